# Optimizing an MI355X kernel written in HIP

```python
import math
import jax, jax.numpy as jnp
from jax import lax
import numpy as np

D_MODEL = 2048
BATCH = 16
SEQ = 2048
DEPTH = 1

D_MIX = D_MODEL
A_HEADS = 8
A_QK_DIM = 64
A_V_DIM = 2 * A_QK_DIM
A_WIDTH = A_HEADS * A_V_DIM
B_HEADS = 8
B_LAT = 256
B_V_DIM = 128
B_WIDTH = B_HEADS * B_V_DIM
IDX_HEADS = 16
IDX_DIM = 64
TOPK_MAX = 256
N_BUCKETS = 32
MAX_DISTANCE = 128
N_BIAS_HEADS = A_HEADS + B_HEADS
Q_BLOCK = 128
EPS = 1e-6

IN_SIZES = (
    2 * A_HEADS * A_QK_DIM,
    2 * A_HEADS * A_QK_DIM,
    A_HEADS * A_V_DIM,
    A_WIDTH,
    B_HEADS * B_LAT,
    B_LAT,
    B_WIDTH,
    IDX_HEADS * IDX_DIM,
    IDX_DIM,
    IDX_HEADS,
)
N_IN = 2 * A_HEADS * A_QK_DIM * 2 + A_HEADS * A_V_DIM + A_WIDTH + B_HEADS * B_LAT + B_LAT + B_WIDTH + IDX_HEADS * IDX_DIM + IDX_DIM + IDX_HEADS

kernel_name = "hymba_diff_dsa_hybrid_layer"


def _split_points():
    pts, acc = [], 0
    for s in IN_SIZES[:-1]:
        acc += s
        pts.append(acc)
    return pts


def rmsnorm(x, g):
    xf = x.astype(jnp.float32)
    y = xf * lax.rsqrt(jnp.mean(xf * xf, axis=-1, keepdims=True) + EPS)
    return (y * g.astype(jnp.float32)).astype(x.dtype)


def t5_bucket(dist):
    n = jnp.maximum(dist, 0)
    max_exact = N_BUCKETS // 2
    nf = jnp.maximum(n, 1).astype(jnp.float32)
    large = max_exact + (jnp.log(nf / max_exact) / math.log(MAX_DISTANCE / max_exact)
                         * (N_BUCKETS - max_exact)).astype(jnp.int32)
    large = jnp.minimum(large, N_BUCKETS - 1)
    return jnp.where(n < max_exact, n, large)


def diff_attention(q, k, v, bias_tab, lam, sub_g, lam_init):
    B, T = q.shape[0], q.shape[1]
    scale = A_QK_DIM ** -0.5
    pos = jnp.arange(T)
    neg = jnp.finfo(jnp.float32).min

    def block(i):
        q0 = i * Q_BLOCK
        qb = lax.dynamic_slice_in_dim(q, q0, Q_BLOCK, axis=1)
        tq = q0 + jnp.arange(Q_BLOCK)
        dist = tq[:, None] - pos[None, :]
        bias = jnp.transpose(bias_tab[t5_bucket(dist)], (2, 0, 1))
        logits = jnp.einsum('btchd,bschd->bchts', qb, k).astype(jnp.float32) * scale + bias
        logits = jnp.where(dist >= 0, logits, neg)
        p = jax.nn.softmax(logits, axis=-1)
        a = p[:, 0] - lam * p[:, 1]
        return jnp.einsum('bhts,bshd->bthd', a.astype(v.dtype), v)

    o = lax.map(block, jnp.arange(T // Q_BLOCK))
    o = jnp.transpose(o, (1, 0, 2, 3, 4)).reshape(B, T, A_HEADS, A_V_DIM)
    return rmsnorm(o, sub_g) * (1.0 - lam_init)


def dsa_attention(q, ckv, iq, ik, iw, bias_tab, w_uv):
    B, T = q.shape[0], q.shape[1]
    S = ckv.shape[1]
    topk = min(TOPK_MAX, S // 4)
    scale = B_LAT ** -0.5
    idx_scale = IDX_DIM ** -0.5
    head_w_scale = IDX_HEADS ** -0.5
    pos = jnp.arange(S)
    neg = jnp.finfo(jnp.float32).min
    gather = jax.vmap(lambda c, s: c[s])

    def block(i):
        q0 = i * Q_BLOCK
        qb = lax.dynamic_slice_in_dim(q, q0, Q_BLOCK, axis=1)
        iqb = lax.dynamic_slice_in_dim(iq, q0, Q_BLOCK, axis=1)
        iwb = lax.dynamic_slice_in_dim(iw, q0, Q_BLOCK, axis=1)
        tq = q0 + jnp.arange(Q_BLOCK)
        rel = jax.nn.relu(jnp.einsum('bthd,bsd->bths', iqb, ik).astype(jnp.float32) * idx_scale)
        score = jnp.einsum('bths,bth->bts', rel, iwb.astype(jnp.float32) * head_w_scale)
        score = jnp.where(pos[None, None, :] <= tq[None, :, None], score, neg)
        _, sel = lax.top_k(score, topk)
        valid = sel <= tq[None, :, None]
        kv_sel = gather(ckv, sel)
        bias = bias_tab[t5_bucket(tq[None, :, None] - sel)]
        logits = (jnp.einsum('bthc,btkc->bhtk', qb, kv_sel).astype(jnp.float32) * scale
                  + jnp.transpose(bias, (0, 3, 1, 2)))
        logits = jnp.where(valid[:, None], logits, neg)
        p = jax.nn.softmax(logits, axis=-1)
        o_lat = jnp.einsum('bhtk,btkc->bthc', p.astype(kv_sel.dtype), kv_sel)
        return jnp.einsum('bthc,hcd->bthd', o_lat, w_uv)

    o = lax.map(block, jnp.arange(T // Q_BLOCK))
    return jnp.transpose(o, (1, 0, 2, 3, 4)).reshape(B, T, B_HEADS, B_V_DIM)


def setup_inputs(seed: int = 0) -> dict:
    key = jax.random.key(seed)
    ks = jax.random.split(key, 16)
    f32 = jnp.float32
    nrm = lambda k, shape, s: (jax.random.normal(k, shape, f32) * s)
    return {
        "x": nrm(ks[0], (BATCH, SEQ, D_MODEL), 1.0),
        "norm_pre_g": 1.0 + nrm(ks[1], (DEPTH, D_MODEL), 0.02),
        "w_in": nrm(ks[2], (DEPTH, D_MODEL, N_IN), D_MODEL ** -0.5),
        "lambda_q1": nrm(ks[3], (DEPTH, A_QK_DIM), 0.1),
        "lambda_k1": nrm(ks[4], (DEPTH, A_QK_DIM), 0.1),
        "lambda_q2": nrm(ks[5], (DEPTH, A_QK_DIM), 0.1),
        "lambda_k2": nrm(ks[6], (DEPTH, A_QK_DIM), 0.1),
        "subln_g": 1.0 + nrm(ks[7], (DEPTH, A_V_DIM), 0.02),
        "kv_norm_g": 1.0 + nrm(ks[8], (DEPTH, B_LAT), 0.02),
        "idx_k_norm_g": 1.0 + nrm(ks[9], (DEPTH, IDX_DIM), 0.02),
        "w_uv": nrm(ks[10], (DEPTH, B_HEADS, B_LAT, B_V_DIM), B_LAT ** -0.5),
        "rel_bias": nrm(ks[11], (N_BUCKETS, N_BIAS_HEADS), 0.1),
        "w_out": nrm(ks[12], (DEPTH, D_MIX, D_MODEL), D_MIX ** -0.5),
        "norm_post_g": 1.0 + nrm(ks[13], (DEPTH, D_MODEL), 0.02),
    }


def reference(x, norm_pre_g, w_in, lambda_q1, lambda_k1, lambda_q2, lambda_k2, subln_g,
              kv_norm_g, idx_k_norm_g, w_uv, rel_bias, w_out, norm_post_g):
    B, T, _ = x.shape
    pts = _split_points()
    bias_a = rel_bias[:, :A_HEADS]
    bias_b = rel_bias[:, A_HEADS:]
    for l in range(DEPTH):
        lam_init = 0.8 - 0.6 * math.exp(-0.3 * l)
        h = rmsnorm(x, norm_pre_g[l])
        proj = jnp.einsum('btd,dn->btn', h, w_in[l])
        qa, ka, va, za, qb, ckv, zb, iq, ik, iw = jnp.split(proj, pts, axis=-1)

        lam = (jnp.exp(jnp.sum(lambda_q1[l].astype(jnp.float32) * lambda_k1[l].astype(jnp.float32)))
               - jnp.exp(jnp.sum(lambda_q2[l].astype(jnp.float32) * lambda_k2[l].astype(jnp.float32)))
               + lam_init)
        o_a = diff_attention(qa.reshape(B, T, 2, A_HEADS, A_QK_DIM),
                             ka.reshape(B, T, 2, A_HEADS, A_QK_DIM),
                             va.reshape(B, T, A_HEADS, A_V_DIM),
                             bias_a, lam, subln_g[l], lam_init)
        o_a = o_a.reshape(B, T, A_WIDTH) * jax.nn.silu(za)

        o_b = dsa_attention(qb.reshape(B, T, B_HEADS, B_LAT),
                            rmsnorm(ckv, kv_norm_g[l]),
                            iq.reshape(B, T, IDX_HEADS, IDX_DIM),
                            rmsnorm(ik, idx_k_norm_g[l]),
                            iw, bias_b, w_uv[l])
        o_b = o_b.reshape(B, T, B_WIDTH) * jax.nn.silu(zb)

        y = jnp.einsum('btm,md->btd', jnp.concatenate([o_a, o_b], axis=-1), w_out[l])
        x = x + rmsnorm(y, norm_post_g[l])
    return x
```

```cpp
#include <hip/hip_runtime.h>
#include <cstdio>
#include <cstdint>
namespace pg8 {
#define PG8_LAS __attribute__((address_space(3)))
typedef unsigned short bf16_t;
typedef short bf16x8 __attribute__((ext_vector_type(8)));
typedef float f32x4 __attribute__((ext_vector_type(4)));
typedef unsigned u32x4 __attribute__((ext_vector_type(4)));
constexpr int BM = 256, BK = 64, HALF = 128, HTB = HALF * BK * 2  , STAGE_BYTES = 8 * HTB, NXCD = 8, WGM = 8;

__host__ __device__ __forceinline__ int lds_byte(int r, int c) { const int st = (r >> 4) * 2 + (c >> 5), rr = r & 15, cc = c & 31, ob = rr * 64 + cc * 2; return st * 1024 + (ob ^ (((ob >> 9) & 1) << 5)); }
__host__ __device__ __forceinline__ void stage_rc(int b, int& R, int& C) { const int st = b / 1024, sb = b % 1024, swz = sb ^ (((sb >> 9) & 1) << 5); R = (st >> 1) * 16 + swz / 64; C = (st & 1) * 32 + (swz % 64) / 2; }
__host__ __device__ __forceinline__ int perm32(int rho) { const int n = rho >> 4, i = rho & 15; return 8 * (i >> 2) + 4 * n + (i & 3); }

struct Unit { int pm, pn; };
struct Gemm { const bf16_t* A; const bf16_t* Bt; int M, N, K; };

struct StaticOrder {
    int nM, nN, nwg, G, c;
    __host__ __device__ void init(int M, int N, int G_, int c_) { nM = M / BM; nN = N / BM; nwg = nM * nN; G = G_; c = c_; }
    __host__ __device__ bool next(int i, Unit& u) const {
        const long L = (long)i * G + c; if (L >= nwg) return false;
        int wgid = (int)L; { const int q = nwg / NXCD, r = nwg % NXCD, xcd = wgid % NXCD, off = wgid / NXCD; wgid = (xcd < r ? xcd * (q + 1) : r * (q + 1) + (xcd - r) * q) + off; }
        const int nig = WGM * nN, gid = wgid / nig, fm = gid * WGM, gsz = (nM - fm) < WGM ? (nM - fm) : WGM;
        u.pm = fm + ((wgid % nig) % gsz); u.pn = (wgid % nig) / gsz; return true;
    }
    __device__ __forceinline__ void a_ready(const Unit&) const {}
    __device__ __forceinline__ void done(const Unit&) const {}
};

__device__ __forceinline__ unsigned cvt_pk_bf16(float lo, float hi) { unsigned r; asm volatile("v_cvt_pk_bf16_f32 %0, %1, %2" : "=v"(r) : "v"(lo), "v"(hi)); return r; }
typedef float f32x2 __attribute__((ext_vector_type(2)));
__device__ __forceinline__ f32x2 gelu_pk(f32x2 v) {
    const f32x2 av = __builtin_elementwise_abs(v), d = av * 0.2316418882f + 1.0f;
    f32x2 t; t.x = __builtin_amdgcn_rcpf(d.x); t.y = __builtin_amdgcn_rcpf(d.y);
    f32x2 q = t * 0.5307027145f + (-0.7265760135f); q = q * t + 0.7107068705f; q = q * t + (-0.142248368f); q = q * t + 0.127414796f; q = q * t;
    const f32x2 s = (v * v) * (-0.72134752044f);
    f32x2 e; e.x = __builtin_amdgcn_exp2f(s.x); e.y = __builtin_amdgcn_exp2f(s.y);
    const f32x2 m = v * (q * e), r = v - m;
    f32x2 o; o.x = v.x < 0.f ? m.x : r.x; o.y = v.y < 0.f ? m.y : r.y; return o;
}

template <int ACT  > struct EpiBf16 {
    static constexpr bool PERM = true, AFTER_DRAIN = false; static_assert(ACT == 0 || ACT == 1, "EpiBf16: ACT is 0 (none) or 1 (gelu_pk)");
    bf16_t* O; int ldc; const float* bias; int split_cols; size_t split_stride; float scale0;
    __device__ __forceinline__ void operator()(const f32x4 (&acc)[2][2][4][2], const Unit& u, int wr, int wc, int fr, int fq) const {
        const int row0 = u.pm * BM + wr * 64 + fr; int colt = u.pn * BM; bf16_t* base = O;
        float sc = 1.f; if (split_cols) { const int t = colt / split_cols; base += (size_t)t * split_stride; colt -= t * split_cols; if (t == 0) sc = scale0; }
        const int col0 = colt + wc * 32 + 8 * fq, bcol0 = u.pn * BM + wc * 32 + 8 * fq;
        f32x4 bv[2][2];
#pragma unroll
        for (int bj = 0; bj < 2; ++bj)
#pragma unroll
            for (int n = 0; n < 2; ++n) bv[bj][n] = bias ? *(const f32x4*)(bias + bcol0 + bj * HALF + 4 * n) : (f32x4){0.f, 0.f, 0.f, 0.f};
#pragma unroll
        for (int ai = 0; ai < 2; ++ai)
#pragma unroll
            for (int m = 0; m < 4; ++m) { bf16_t* rowp = base + (size_t)(row0 + ai * HALF + m * 16) * ldc + col0;
#pragma unroll
                for (int bj = 0; bj < 2; ++bj) { f32x4 v0 = acc[ai][bj][m][0] + bv[bj][0], v1 = acc[ai][bj][m][1] + bv[bj][1];
                    if (ACT == 1) { f32x2 a = gelu_pk((f32x2){v0[0], v0[1]}), b = gelu_pk((f32x2){v0[2], v0[3]}), c = gelu_pk((f32x2){v1[0], v1[1]}), d = gelu_pk((f32x2){v1[2], v1[3]});
                        v0 = (f32x4){a.x, a.y, b.x, b.y}; v1 = (f32x4){c.x, c.y, d.x, d.y}; }
                    v0 = v0 * sc; v1 = v1 * sc; u32x4 w; w.x = cvt_pk_bf16(v0[0], v0[1]); w.y = cvt_pk_bf16(v0[2], v0[3]); w.z = cvt_pk_bf16(v1[0], v1[1]); w.w = cvt_pk_bf16(v1[2], v1[3]);
                    *(u32x4*)(rowp + bj * HALF) = w; } }
    }
};

struct PanelStats {
    unsigned* xbuf;
    unsigned* cnt;
    unsigned* tmo;
    int ntn; float eps;
    unsigned code;
    __device__ __forceinline__ bool run(const f32x4 (&v)[2][2][4][2], const Unit& u, int wr, int wc, int fr, int fq, PG8_LAS unsigned char* lds, int wid, int lane) const {
        typedef float f32x2v __attribute__((ext_vector_type(2)));
        PG8_LAS f32x2v* P = (PG8_LAS f32x2v*)lds;
        PG8_LAS f32x2v* S = (PG8_LAS f32x2v*)(lds + 8192);
        PG8_LAS unsigned* flag = (PG8_LAS unsigned*)(lds + 8192 + 2048);
#pragma unroll
        for (int ai = 0; ai < 2; ++ai)
#pragma unroll
            for (int m = 0; m < 4; ++m) {
                float s = 0.f;
#pragma unroll
                for (int bj = 0; bj < 2; ++bj)
#pragma unroll
                    for (int n = 0; n < 2; ++n) { const f32x4 x = v[ai][bj][m][n]; s += (x[0] + x[1]) + (x[2] + x[3]); }
                s += __shfl_xor(s, 16); s += __shfl_xor(s, 32);
                const float mw = s * (1.0f / 64.0f); float q = 0.f;
#pragma unroll
                for (int bj = 0; bj < 2; ++bj)
#pragma unroll
                    for (int n = 0; n < 2; ++n) { const f32x4 d = v[ai][bj][m][n] - mw; q += (d[0] * d[0] + d[1] * d[1]) + (d[2] * d[2] + d[3] * d[3]); }
                q += __shfl_xor(q, 16); q += __shfl_xor(q, 32);
                if (fq == 0) P[(ai * HALF + wr * 64 + m * 16 + fr) * 4 + wc] = (f32x2v){mw, q};
            }
        asm volatile("s_waitcnt lgkmcnt(0)" ::: "memory"); __builtin_amdgcn_s_barrier(); asm volatile("" ::: "memory");
#if defined(BROKEN_EXCHANGE_NO_WAIT)
#warning BROKEN CONTROL BUILD: the row-statistics exchange does not wait; results are wrong by design
        if (blockIdx.x >= 64) { const long long t0_ = clock64(); while (clock64() - t0_ < 60000) __builtin_amdgcn_s_sleep(8); }
#endif
        const int row = wid * 32 + (lane & 31);
        if (lane < 32) {
            const f32x2v a = P[row * 4 + 0], b = P[row * 4 + 1], c = P[row * 4 + 2], d = P[row * 4 + 3];
            const float mt = (a.x + b.x + c.x + d.x) * 0.25f;
            const float da = a.x - mt, db = b.x - mt, dc = c.x - mt, dd = d.x - mt;
            const float m2 = (a.y + b.y) + (c.y + d.y) + 64.0f * ((da * da + db * db) + (dc * dc + dd * dd));
            unsigned long long* slot = (unsigned long long*)xbuf + ((size_t)(u.pm * BM + row) * 4 + u.pn);
            __hip_atomic_store(slot, ((unsigned long long)__float_as_uint(m2) << 32) | __float_as_uint(mt), __ATOMIC_RELAXED, __HIP_MEMORY_SCOPE_AGENT);
        }
        asm volatile("s_waitcnt vmcnt(0)" ::: "memory");
        if (lane == 0) __hip_atomic_fetch_add(cnt + 64 * u.pm, 1u, __ATOMIC_RELAXED, __HIP_MEMORY_SCOPE_AGENT);
        if (wid == 0) {
            bool dead = false; const unsigned long long t0 = __builtin_amdgcn_s_memrealtime(); const unsigned want = 8u * (unsigned)ntn;
            for (;;) {
#if defined(BROKEN_EXCHANGE_NO_WAIT)
                break;
#endif
                if ((unsigned)__builtin_amdgcn_readfirstlane(__hip_atomic_load(cnt + 64 * u.pm, __ATOMIC_RELAXED, __HIP_MEMORY_SCOPE_AGENT)) >= want) break;
                if (__builtin_amdgcn_s_memrealtime() - t0 > 2000000ull) {
                    if (lane == 0) { unsigned expect = 0u; __hip_atomic_compare_exchange_strong(tmo + 1, &expect, code | (unsigned)(u.pm & 0xff), __ATOMIC_RELAXED, __ATOMIC_RELAXED, __HIP_MEMORY_SCOPE_AGENT);
                                     __hip_atomic_store(tmo, 1u, __ATOMIC_RELAXED, __HIP_MEMORY_SCOPE_AGENT); }
                    dead = true; break; }
                __builtin_amdgcn_s_sleep(2);
            }
            __builtin_amdgcn_fence(__ATOMIC_ACQUIRE, "agent");
            if (lane == 0) flag[0] = dead ? 1u : 0u;
        }
        asm volatile("s_waitcnt vmcnt(0) lgkmcnt(0)" ::: "memory"); __builtin_amdgcn_s_barrier(); asm volatile("" ::: "memory");
        const bool bad = flag[0] != 0u;
        if (lane < 32) {
            const unsigned long long* slot = (const unsigned long long*)xbuf + (size_t)(u.pm * BM + row) * 4; float mt[4], m2[4]; float ms = 0.f;
#pragma unroll
            for (int t = 0; t < 4; ++t) { if (t < ntn) { const unsigned long long w = __hip_atomic_load(slot + t, __ATOMIC_RELAXED, __HIP_MEMORY_SCOPE_AGENT); mt[t] = __uint_as_float((unsigned)w); m2[t] = __uint_as_float((unsigned)(w >> 32)); } else { mt[t] = 0.f; m2[t] = 0.f; } ms += mt[t]; }
            const float mean = ms / (float)ntn; float q = 0.f;
#pragma unroll
            for (int t = 0; t < 4; ++t) if (t < ntn) { const float dm = mt[t] - mean; q += m2[t] + 256.0f * dm * dm; }
            S[row] = (f32x2v){mean, 1.0f / sqrtf(q / (256.0f * (float)ntn) + eps)};
        }
        asm volatile("s_waitcnt lgkmcnt(0)" ::: "memory"); __builtin_amdgcn_s_barrier(); asm volatile("" ::: "memory");
        return bad;
    }
};
struct EpiLnRes {
    static constexpr bool PERM = false, AFTER_DRAIN = true;
    const float* base; float* out; int ldc; const float* bias; PanelStats st; unsigned poison;
    __device__ __forceinline__ void fused(f32x4 (&acc)[2][2][4][2], const Unit& u, int wr, int wc, int fr, int fq, PG8_LAS unsigned char* lds, int wid, int lane) const {
        typedef float f32x2v __attribute__((ext_vector_type(2)));
        const PG8_LAS f32x2v* S = (const PG8_LAS f32x2v*)(lds + 8192);
        const int col0 = u.pn * BM + wc * 32 + 4 * fq;
#pragma unroll
        for (int bj = 0; bj < 2; ++bj)
#pragma unroll
            for (int n = 0; n < 2; ++n) { const f32x4 bv = bias ? *(const f32x4*)(bias + col0 + bj * HALF + n * 16) : (f32x4){0.f, 0.f, 0.f, 0.f};
#pragma unroll
                for (int ai = 0; ai < 2; ++ai)
#pragma unroll
                    for (int m = 0; m < 4; ++m) acc[ai][bj][m][n] += bv; }
        f32x4 pre[4][2][2];
#pragma unroll
        for (int m = 0; m < 4; ++m) { const size_t off = (size_t)(u.pm * BM + wr * 64 + m * 16 + fr) * ldc + col0;
#pragma unroll
            for (int bj = 0; bj < 2; ++bj)
#pragma unroll
                for (int n = 0; n < 2; ++n) pre[m][bj][n] = *(const f32x4*)(base + off + bj * HALF + n * 16); }
        const bool bad = st.run(acc, u, wr, wc, fr, fq, lds, wid, lane) || poison != 0u;
        const float qnan = __builtin_nanf("");
#pragma unroll
        for (int ai = 0; ai < 2; ++ai)
#pragma unroll
            for (int m = 0; m < 4; ++m) { const int r = ai * HALF + wr * 64 + m * 16 + fr; const f32x2v sr = S[r]; const size_t off = (size_t)(u.pm * BM + r) * ldc + col0;
#pragma unroll
                for (int bj = 0; bj < 2; ++bj)
#pragma unroll
                    for (int n = 0; n < 2; ++n) { const f32x4 bs = ai == 0 ? pre[m][bj][n] : *(const f32x4*)(base + off + bj * HALF + n * 16); f32x4 o = bs + (acc[ai][bj][m][n] - sr.x) * sr.y;
                        if (bad) o = (f32x4){qnan, qnan, qnan, qnan}; *(f32x4*)(out + off + bj * HALF + n * 16) = o; }
                if (m & 1) asm volatile("" ::: "memory"); }
    }
};
struct EpiLnResLn {
    static constexpr bool PERM = false, AFTER_DRAIN = true;
    const float* base; float* out; bf16_t* xn; int ldc; const float* bias; PanelStats st1, st2; unsigned poison;
    __device__ __forceinline__ void fused(f32x4 (&acc)[2][2][4][2], const Unit& u, int wr, int wc, int fr, int fq, PG8_LAS unsigned char* lds, int wid, int lane) const {
        typedef float f32x2v __attribute__((ext_vector_type(2))); typedef unsigned u32x2v __attribute__((ext_vector_type(2)));
        const PG8_LAS f32x2v* S = (const PG8_LAS f32x2v*)(lds + 8192);
        const int col0 = u.pn * BM + wc * 32 + 4 * fq;
#pragma unroll
        for (int bj = 0; bj < 2; ++bj)
#pragma unroll
            for (int n = 0; n < 2; ++n) { const f32x4 bv = bias ? *(const f32x4*)(bias + col0 + bj * HALF + n * 16) : (f32x4){0.f, 0.f, 0.f, 0.f};
#pragma unroll
                for (int ai = 0; ai < 2; ++ai)
#pragma unroll
                    for (int m = 0; m < 4; ++m) acc[ai][bj][m][n] += bv; }
        bool bad = st1.run(acc, u, wr, wc, fr, fq, lds, wid, lane) || poison != 0u;
        const float qnan = __builtin_nanf("");
#pragma unroll
        for (int ai = 0; ai < 2; ++ai)
#pragma unroll
            for (int m = 0; m < 4; ++m) { const int r = ai * HALF + wr * 64 + m * 16 + fr; const f32x2v sr = S[r]; const size_t off = (size_t)(u.pm * BM + r) * ldc + col0;
#pragma unroll
                for (int bj = 0; bj < 2; ++bj)
#pragma unroll
                    for (int n = 0; n < 2; ++n) { const f32x4 bs = *(const f32x4*)(base + off + bj * HALF + n * 16); acc[ai][bj][m][n] = bs + (acc[ai][bj][m][n] - sr.x) * sr.y; }
                asm volatile("" : "+v"(acc[ai][0][m][0]), "+v"(acc[ai][0][m][1]), "+v"(acc[ai][1][m][0]), "+v"(acc[ai][1][m][1]));
                if (m & 1) asm volatile("" ::: "memory"); }
        const bool bad1 = bad;
        bad = st2.run(acc, u, wr, wc, fr, fq, lds, wid, lane) || bad;
#pragma unroll
        for (int ai = 0; ai < 2; ++ai)
#pragma unroll
            for (int m = 0; m < 4; ++m) { const int r = ai * HALF + wr * 64 + m * 16 + fr; const f32x2v sr = S[r]; const size_t off = (size_t)(u.pm * BM + r) * ldc + col0;
#pragma unroll
                for (int bj = 0; bj < 2; ++bj)
#pragma unroll
                    for (int n = 0; n < 2; ++n) { const f32x4 x1 = acc[ai][bj][m][n]; *(f32x4*)(out + off + bj * HALF + n * 16) = bad1 ? (f32x4){qnan, qnan, qnan, qnan} : x1;
                        const f32x4 o = (x1 - sr.x) * sr.y; u32x2v w; w.x = cvt_pk_bf16(o[0], o[1]); w.y = cvt_pk_bf16(o[2], o[3]);
                        if (bad) { w.x = 0x7fc07fc0u; w.y = 0x7fc07fc0u; } *(u32x2v*)(xn + off + bj * HALF + n * 16) = w; }
                asm volatile("" ::: "memory"); }
    }
};

template <class Epi, class Sched, bool ALIGN_EPI = false, bool SP2 = false>
__device__ __forceinline__ void gemm_phase(PG8_LAS unsigned char* lds, const Gemm g, const Sched& S, const Epi& E) {
    const int tid = threadIdx.x, wid = __builtin_amdgcn_readfirstlane(tid >> 6), lane = tid & 63, wr = wid >> 2, wc = wid & 3, fr = lane & 15, fq = lane >> 4;
    const int K = g.K, nt = K / BK;
    unsigned voffA[2], voffB[2];
#pragma unroll
    for (int i = 0; i < 2; ++i) { int R, C; stage_rc(tid * 16 + i * 8192, R, C); const int Rb = Epi::PERM ? ((R & ~31) + perm32(R & 31)) : R;
        voffA[i] = (unsigned)(R * K + C) * 2u; voffB[i] = (unsigned)(Rb * K + C) * 2u; }
    const size_t kstep = (size_t)(BK * 2);
    const size_t hstep = (size_t)HALF * K * 2;
    const size_t tstep = 2 * hstep;
    const unsigned ldsw = (unsigned)wid * 1024u;
    const int aoff = lds_byte(wr * 64 + fr, fq * 8), boff = lds_byte(wc * 32 + fr, fq * 8);
#define PG8_SA(b, h) (((b) * 2 + (h)) * HTB)
#define PG8_SB(b, h) ((4 + (b) * 2 + (h)) * HTB)
#define PG8_STAGE(bufoff, gbase, voff) do { _Pragma("unroll") for (int _i = 0; _i < 2; ++_i) \
        __builtin_amdgcn_global_load_lds((const unsigned*)((const char*)(gbase) + (voff)[_i]), (PG8_LAS unsigned*)(lds + (bufoff) + ldsw + _i * 8192), 16, 0, 0); } while (0)
#define PG8_LDA(dst, b, h) do { _Pragma("unroll") for (int m = 0; m < 4; ++m) _Pragma("unroll") for (int k = 0; k < 2; ++k) dst[m][k] = *(const PG8_LAS bf16x8*)(lds + PG8_SA(b, h) + aoff + m * 2048 + k * 1024); } while (0)
#define PG8_LDB(dst, b, h) do { _Pragma("unroll") for (int n = 0; n < 2; ++n) _Pragma("unroll") for (int k = 0; k < 2; ++k) dst[n][k] = *(const PG8_LAS bf16x8*)(lds + PG8_SB(b, h) + boff + n * 2048 + k * 1024); } while (0)
#define PG8_MMA(ai, bj, At, Bt) do { __builtin_amdgcn_s_setprio(1); _Pragma("unroll") for (int m = 0; m < 4; ++m) _Pragma("unroll") for (int n = 0; n < 2; ++n) _Pragma("unroll") for (int k = 0; k < 2; ++k) \
        acc[ai][bj][m][n] = __builtin_amdgcn_mfma_f32_16x16x32_bf16(Bt[n][k], At[m][k], acc[ai][bj][m][n], 0, 0, 0); __builtin_amdgcn_s_setprio(0); } while (0)
#define PG8_WAIT_V(n) asm volatile("s_waitcnt vmcnt(" #n ")" ::: "memory")
#define PG8_WAIT_L(n) asm volatile("s_waitcnt lgkmcnt(" #n ")" ::: "memory")
#define PG8_BAR __builtin_amdgcn_s_barrier()
#define PG8_SCHED __builtin_amdgcn_sched_barrier(0)
    Unit cur, nxt; int ui = 0;
    if (!S.next(0, cur)) return;
    f32x4 acc[2][2][4][2];
#pragma unroll
    for (int a = 0; a < 2; ++a)
#pragma unroll
        for (int b = 0; b < 2; ++b)
#pragma unroll
            for (int m = 0; m < 4; ++m)
#pragma unroll
                for (int n = 0; n < 2; ++n) acc[a][b][m][n] = (f32x4){0.f, 0.f, 0.f, 0.f};
    bf16x8 At[4][2], B0[2][2], B1[2][2];
    const char* cA = (const char*)g.A + (size_t)cur.pm * tstep; const char* cB = (const char*)g.Bt + (size_t)cur.pn * tstep;
    S.a_ready(cur);
    if constexpr (SP2) {
        PG8_STAGE(PG8_SB(0, 0), cB, voffB); PG8_STAGE(PG8_SB(0, 1), cB + hstep, voffB); PG8_STAGE(PG8_SA(0, 0), cA, voffA); PG8_STAGE(PG8_SA(0, 1), cA + hstep, voffA);
        if (wr == 1) PG8_BAR;
        PG8_WAIT_V(2); PG8_BAR;
        PG8_STAGE(PG8_SB(1, 0), cB + kstep, voffB); PG8_STAGE(PG8_SA(1, 0), cA + kstep, voffA); PG8_STAGE(PG8_SB(1, 1), cB + hstep + kstep, voffB);
        PG8_WAIT_V(6); PG8_BAR;
    } else {
        PG8_STAGE(PG8_SB(0, 0), cB, voffB); PG8_STAGE(PG8_SA(0, 0), cA, voffA); PG8_STAGE(PG8_SB(0, 1), cB + hstep, voffB); PG8_STAGE(PG8_SA(0, 1), cA + hstep, voffA);
        if (wr == 1) PG8_BAR;
        PG8_WAIT_V(4); PG8_BAR;
        PG8_STAGE(PG8_SB(1, 0), cB + kstep, voffB); PG8_STAGE(PG8_SA(1, 0), cA + kstep, voffA); PG8_STAGE(PG8_SB(1, 1), cB + hstep + kstep, voffB);
        PG8_WAIT_V(6); PG8_BAR;
    }
    for (;;) {
        const bool has_next = S.next(ui + 1, nxt);
        const char* nA = has_next ? (const char*)g.A + (size_t)nxt.pm * tstep : cA; const char* nB = has_next ? (const char*)g.Bt + (size_t)nxt.pn * tstep : cB;
        for (int t = 0; t < nt; t += 2) {
            const bool last = (t == nt - 2);
            const char* a1 = cA + (size_t)(t + 1) * kstep;
            const char* a2 = last ? nA : cA + (size_t)(t + 2) * kstep; const char* b2 = last ? nB : cB + (size_t)(t + 2) * kstep;
            const char* a3 = a2 + kstep; const char* b3 = b2 + kstep;
            if (last && has_next) S.a_ready(nxt);
            if constexpr (SP2) {
            PG8_LDB(B0, 0, 0); PG8_LDB(B1, 0, 1); PG8_SCHED; PG8_LDA(At, 0, 0); PG8_STAGE(PG8_SA(1, 1), a1 + hstep, voffA);
            PG8_WAIT_V(8); PG8_WAIT_L(0); PG8_BAR; PG8_MMA(0, 0, At, B0); PG8_MMA(0, 1, At, B1); PG8_BAR; PG8_SCHED;
            PG8_LDA(At, 0, 1); PG8_STAGE(PG8_SB(0, 0), b2, voffB); PG8_STAGE(PG8_SB(0, 1), b2 + hstep, voffB); PG8_STAGE(PG8_SA(0, 0), a2, voffA);
            PG8_WAIT_V(8); PG8_WAIT_L(0); PG8_BAR; PG8_MMA(1, 0, At, B0); PG8_MMA(1, 1, At, B1); PG8_BAR; PG8_SCHED;
            PG8_LDB(B0, 1, 0); PG8_LDB(B1, 1, 1); PG8_SCHED; PG8_LDA(At, 1, 0); PG8_STAGE(PG8_SA(0, 1), a2 + hstep, voffA);
            PG8_WAIT_V(8); PG8_WAIT_L(0); PG8_BAR; PG8_MMA(0, 0, At, B0); PG8_MMA(0, 1, At, B1); PG8_BAR; PG8_SCHED;
            PG8_LDA(At, 1, 1); PG8_STAGE(PG8_SB(1, 0), b3, voffB); PG8_STAGE(PG8_SB(1, 1), b3 + hstep, voffB); PG8_STAGE(PG8_SA(1, 0), a3, voffA);
            PG8_WAIT_V(8); PG8_WAIT_L(0); PG8_BAR; PG8_MMA(1, 0, At, B0); PG8_MMA(1, 1, At, B1); PG8_BAR; PG8_SCHED;
            } else {
            PG8_LDB(B0, 0, 0); PG8_SCHED; PG8_LDA(At, 0, 0); PG8_STAGE(PG8_SA(1, 1), a1 + hstep, voffA);
            PG8_WAIT_L(8); PG8_BAR; PG8_WAIT_L(0); PG8_MMA(0, 0, At, B0); PG8_BAR; PG8_SCHED;
            PG8_LDB(B1, 0, 1); PG8_STAGE(PG8_SB(0, 0), b2, voffB);
            PG8_BAR; PG8_WAIT_L(0); PG8_MMA(0, 1, At, B1); PG8_BAR;
            PG8_LDA(At, 0, 1); PG8_STAGE(PG8_SA(0, 0), a2, voffA);
            PG8_BAR; PG8_WAIT_L(0); PG8_MMA(1, 0, At, B0); PG8_BAR; PG8_SCHED;
            PG8_STAGE(PG8_SB(0, 1), b2 + hstep, voffB);
            PG8_WAIT_V(6); PG8_BAR; PG8_MMA(1, 1, At, B1); PG8_BAR;
            PG8_LDB(B0, 1, 0); PG8_SCHED; PG8_LDA(At, 1, 0); PG8_STAGE(PG8_SA(0, 1), a2 + hstep, voffA);
            PG8_WAIT_L(8); PG8_BAR; PG8_WAIT_L(0); PG8_MMA(0, 0, At, B0); PG8_BAR; PG8_SCHED;
            PG8_LDB(B1, 1, 1); PG8_STAGE(PG8_SB(1, 0), b3, voffB);
            PG8_BAR; PG8_WAIT_L(0); PG8_MMA(0, 1, At, B1); PG8_BAR;
            PG8_LDA(At, 1, 1); PG8_STAGE(PG8_SA(1, 0), a3, voffA);
            PG8_BAR; PG8_WAIT_L(0); PG8_MMA(1, 0, At, B0); PG8_BAR; PG8_SCHED;
            PG8_STAGE(PG8_SB(1, 1), b3 + hstep, voffB);
            PG8_WAIT_V(6); PG8_BAR; PG8_MMA(1, 1, At, B1); PG8_BAR;
            }
        }
        if constexpr (ALIGN_EPI) { if (wr == 0) PG8_BAR; }
        if constexpr (!Epi::AFTER_DRAIN) { E(acc, cur, wr, wc, fr, fq); S.done(cur); }
        if (!has_next) break;
#pragma unroll
        for (int a = 0; a < 2; ++a)
#pragma unroll
            for (int b = 0; b < 2; ++b)
#pragma unroll
                for (int m = 0; m < 4; ++m)
#pragma unroll
                    for (int n = 0; n < 2; ++n) acc[a][b][m][n] = (f32x4){0.f, 0.f, 0.f, 0.f};
        cur = nxt; cA = nA; cB = nB; ++ui;
        if constexpr (ALIGN_EPI) { if (wr == 1) PG8_BAR; }
    }
    PG8_WAIT_V(0);
    if constexpr (!ALIGN_EPI) { if (wr == 0) PG8_BAR; }
    PG8_BAR;
    if constexpr (Epi::AFTER_DRAIN) { E.fused(acc, cur, wr, wc, fr, fq, lds, wid, lane); S.done(cur); }
#undef PG8_SA
#undef PG8_SB
#undef PG8_STAGE
#undef PG8_LDA
#undef PG8_LDB
#undef PG8_MMA
#undef PG8_WAIT_V
#undef PG8_WAIT_L
#undef PG8_BAR
#undef PG8_SCHED
}
}

#ifndef PG8_SP2
#define PG8_SP2 true
#endif
#ifndef PG8_ALIGN
#define PG8_ALIGN true
#endif
constexpr int NWAVES = 8;
#ifndef MK_N_LAUNCHES
#define MK_N_LAUNCHES 1
#endif
constexpr int N_LAUNCHES = MK_N_LAUNCHES;
constexpr int PER_PHASE = 6;

constexpr int BATCH = 16, T = 2048, D = 2048, M = BATCH * T;
constexpr int NIN = 8528, NINP = 8704;
constexpr int C_QA = 0, C_KA = 1024, C_VA = 2048, C_ZA = 3072, C_QB = 4096, C_CKV = 6144, C_ZB = 6400, C_IQ = 7424, C_IK = 8448, C_IW = 8512;
constexpr int DO = 2048;
constexpr int TOPK = 256;
constexpr float EPS = 1e-6f;

constexpr size_t MiB = 1u << 20;
constexpr size_t WS_CTL = 0, CTL_ZERO_BYTES = 1 * MiB;
constexpr size_t WS_WIN = 2 * MiB;
constexpr size_t WS_WOUT = 36 * MiB;
constexpr size_t WS_WUV = 44 * MiB;
constexpr size_t WS_CKV = 48 * MiB;
constexpr size_t WS_IK = 64 * MiB;
constexpr size_t WS_H = 72 * MiB;
constexpr size_t WS_P = 200 * MiB;
constexpr size_t WS_END = 744 * MiB;
constexpr int CW_TMO = 0, CW_CODE = 1;
constexpr int CW_BAR = 4096;

constexpr int RING_OFF = 0, RING_BYTES = 131072;
constexpr int LDSCTL_OFF = RING_BYTES, MISC_OFF = LDSCTL_OFF + 320;
constexpr int UP_OFF = MISC_OFF + 128;
constexpr int LDS_BYTES = 147456;
static_assert(UP_OFF + 8 * 1024 <= LDS_BYTES, "LDS map");
#define GAS __attribute__((address_space(1)))
#define LAS __attribute__((address_space(3)))
typedef unsigned short bf16;
typedef unsigned v4u __attribute__((ext_vector_type(4)));
typedef float f32x4 __attribute__((ext_vector_type(4)));
typedef short bf16x8 __attribute__((ext_vector_type(8)));
typedef GAS unsigned gu32;
typedef GAS unsigned long long gu64;
#define RLX_AGENT __ATOMIC_RELAXED, __HIP_MEMORY_SCOPE_AGENT
#define LDS_WAIT() asm volatile("s_waitcnt lgkmcnt(0)" ::: "memory")
#define VM_WAIT() asm volatile("s_waitcnt vmcnt(0)" ::: "memory")
__device__ __forceinline__ unsigned long long rt() { return __builtin_amdgcn_s_memrealtime(); }
__device__ __forceinline__ unsigned f2bf(float f) { unsigned u = __builtin_bit_cast(unsigned, f); return (u + 0x7fffu + ((u >> 16) & 1u)) >> 16; }
__device__ __forceinline__ unsigned pk2(float lo, float hi) { return f2bf(lo) | (f2bf(hi) << 16); }

#define XB_TMO      128
#define XB_XCNT(j)  (256  + 64 * (j))
#define XB_XSUB(j)  (1280 + 64 * (j))
#define XB_XGEN(j)  (2304 + 64 * (j))
#define XB_TOP      3328
#define XB_TOPGEN   3392
#define XCD_BAR_WORDS 3456
#define XB_SPIN_CAP (1u << 24)

__device__ __forceinline__ unsigned xb_ld(unsigned* p)              { return __hip_atomic_load(p, __ATOMIC_RELAXED, __HIP_MEMORY_SCOPE_AGENT); }
__device__ __forceinline__ unsigned xb_add(unsigned* p, unsigned v) { return __hip_atomic_fetch_add(p, v, __ATOMIC_RELAXED, __HIP_MEMORY_SCOPE_AGENT); }
__device__ __forceinline__ unsigned xb_xcc_id() { return (unsigned)__builtin_amdgcn_s_getreg((3 << 11) | 20) & 0xFu; }
#define XB_SPIN(cond, bar) do { unsigned _sp = 0; while (cond) { __builtin_amdgcn_s_sleep(1); \
    if ((++_sp & 255u) == 0u) { if (xb_ld(&(bar)[XB_TMO])) break; if (_sp > XB_SPIN_CAP) { atomicAdd(&(bar)[XB_TMO], 1u); break; } } } } while (0)

struct XcdBarrier {
    unsigned* bar; unsigned x;
    volatile LAS unsigned* st;
};

__device__ __forceinline__ XcdBarrier xcd_barrier_post(unsigned* bar, volatile LAS unsigned* st) {
    XcdBarrier b; b.bar = bar; b.x = xb_xcc_id(); b.st = st;
    if (threadIdx.x == 0) (void)xb_add(&bar[XB_XCNT(b.x)], 1u);
    return b;
}
__device__ __forceinline__ void xcd_barrier_complete(unsigned* bar, unsigned x, unsigned& nloc, unsigned& nx) {
    const unsigned G = gridDim.x * gridDim.y * gridDim.z;
    unsigned sum, cnt, mine, sp = 0u;
    for (;;) {
        sum = 0u; cnt = 0u; mine = 0u;
#pragma unroll
        for (unsigned j = 0; j < 16; ++j) { const unsigned c = xb_ld(&bar[XB_XCNT(j)]); sum += c; cnt += (c > 0u) ? 1u : 0u; mine = (j == x) ? c : mine; }
        if (sum == G) break;
        __builtin_amdgcn_s_sleep(1);
        if ((++sp & 255u) == 0u) { if (xb_ld(&bar[XB_TMO])) break; if (sp > XB_SPIN_CAP) { atomicAdd(&bar[XB_TMO], 1u); break; } }
    }
    nloc = mine > 0u ? mine : 1u; nx = cnt > 0u ? cnt : 1u;
}

__device__ __forceinline__ void xcd_barrier(const XcdBarrier& b) {
    asm volatile("s_waitcnt vmcnt(0)" ::: "memory");
    __syncthreads();
    if (threadIdx.x == 0) {
        unsigned* bar = b.bar;
        __builtin_amdgcn_s_waitcnt(0);
        unsigned nloc = b.st[0], nx = b.st[1];
        if (nloc == 0u) { xcd_barrier_complete(bar, b.x, nloc, nx); b.st[0] = nloc; b.st[1] = nx; }
        const unsigned old = xb_add(&bar[XB_XSUB(b.x)], 1u);
        const unsigned gen = old / nloc;
        if (old + 1u == (gen + 1u) * nloc) {
            __builtin_amdgcn_fence(__ATOMIC_RELEASE, "agent");
            asm volatile("s_waitcnt vmcnt(0)" ::: "memory");
            const unsigned og = xb_add(&bar[XB_TOP], 1u);
            const unsigned tg = og / nx;
            if (og + 1u == (tg + 1u) * nx) xb_add(&bar[XB_TOPGEN], 1u);
            else XB_SPIN(xb_ld(&bar[XB_TOPGEN]) == tg, bar);
            __builtin_amdgcn_fence(__ATOMIC_ACQUIRE, "agent");
            xb_add(&bar[XB_XGEN(b.x)], 1u);
            asm volatile("s_waitcnt vmcnt(0)" ::: "memory");
        } else {
            XB_SPIN(xb_ld(&bar[XB_XGEN(b.x)]) == gen, bar);
            __builtin_amdgcn_fence(__ATOMIC_ACQUIRE, "agent");
            asm volatile("s_waitcnt vmcnt(0)" ::: "memory");
        }
    }
    __syncthreads();
}
struct Frame {
    LAS unsigned char* lds;
    volatile LAS unsigned* MISC;
    gu32* ctl;
    int tid, lane, wave;
    int vcu, G;
    const float *x, *g_pre, *w_in, *lq1, *lk1, *lq2, *lk2, *subln_g, *kvn_g, *ikn_g, *w_uv, *rel_bias, *w_out, *g_post;
    float* out;
    bf16 *WinT, *WoutT, *WuvT, *CKVn, *IKn, *H, *O, *P, *Y;
};

__device__ __forceinline__ float wave_sum(float v) {
#pragma unroll
    for (int o = 1; o < 64; o <<= 1) v += __shfl_xor(v, o);
    return v;
}
__device__ __forceinline__ float wave_max(float v) {
#pragma unroll
    for (int o = 1; o < 64; o <<= 1) v = fmaxf(v, __shfl_xor(v, o));
    return v;
}
__device__ __forceinline__ float bf2f(unsigned short b) { return __uint_as_float((unsigned)b << 16); }
__device__ __forceinline__ float bflo(unsigned w) { return __uint_as_float(w << 16); }
__device__ __forceinline__ float bfhi(unsigned w) { return __uint_as_float(w & 0xffff0000u); }
__device__ __forceinline__ float silu(float z) { return z / (1.f + __expf(-z)); }
__device__ __forceinline__ int t5_bucket(int n) {
    if (n < 16) return n;
    return 16 + (n >= 19) + (n >= 21) + (n >= 24) + (n >= 27) + (n >= 31) + (n >= 35) + (n >= 40) + (n >= 46) + (n >= 52) + (n >= 59) + (n >= 67) + (n >= 77) + (n >= 87) + (n >= 99) + (n >= 113);
}

__device__ __forceinline__ void p0_transpose_item(const float* W, int K, int N, int nblk, bf16* WT, LAS float* scr, int item, int lane) {
    const int kb = item / nblk, nb = item % nblk, k0 = 64 * kb, n0 = 32 * nb;
    const int ncol = n0 + (lane & 31); const bool ok = ncol < N;
#pragma unroll 8
    for (int i = 0; i < 32; ++i) { const int kk = 2 * i + (lane >> 5); scr[kk * 33 + (lane & 31)] = ok ? W[(size_t)(k0 + kk) * N + ncol] : 0.f; }
    LDS_WAIT(); asm volatile("" ::: "memory");
    const int c = lane & 7;
#pragma unroll
    for (int j = 0; j < 4; ++j) { const int n = (lane >> 3) + 8 * j; const LAS float* s = scr + (8 * c) * 33 + n;
        v4u o; o.x = pk2(s[0 * 33], s[1 * 33]); o.y = pk2(s[2 * 33], s[3 * 33]); o.z = pk2(s[4 * 33], s[5 * 33]); o.w = pk2(s[6 * 33], s[7 * 33]);
        *(GAS v4u*)(WT + (size_t)(n0 + n) * K + k0 + 8 * c) = o; }
    LDS_WAIT(); asm volatile("" ::: "memory");
}
__device__ __forceinline__ void rms_row_to_bf16(const float* xrow, const float* g, bf16* orow, int lane) {
    const GAS f32x4* xr = (const GAS f32x4*)xrow + lane; const GAS f32x4* gr = (const GAS f32x4*)g + lane;
    f32x4 v[8]; float s = 0.f;
#pragma unroll
    for (int j = 0; j < 8; ++j) { v[j] = xr[64 * j]; s += (v[j].x * v[j].x + v[j].y * v[j].y) + (v[j].z * v[j].z + v[j].w * v[j].w); }
    const float rstd = rsqrtf(wave_sum(s) * (1.f / D) + EPS);
    GAS unsigned long long* o8 = (GAS unsigned long long*)orow + lane;
#pragma unroll
    for (int j = 0; j < 8; ++j) { const f32x4 gg = gr[64 * j];
        o8[64 * j] = (unsigned long long)pk2(v[j].x * rstd * gg.x, v[j].y * rstd * gg.y) | ((unsigned long long)pk2(v[j].z * rstd * gg.z, v[j].w * rstd * gg.w) << 32); }
}
__device__ __forceinline__ void p0_prologue(Frame& F) {
    LAS float* scr = (LAS float*)(F.lds + RING_OFF + F.wave * 16384);
    const int gw = F.vcu * NWAVES + F.wave, NGW = F.G * NWAVES;
    constexpr int I_IN = (D / 64) * (NINP / 32), I_OUT = (DO / 64) * (D / 32);
    for (int it = gw; it < I_IN + I_OUT; it += NGW) {
        if (it < I_IN) p0_transpose_item(F.w_in, D, NIN, NINP / 32, F.WinT, scr, it, F.lane);
        else p0_transpose_item(F.w_out, DO, D, D / 32, F.WoutT, scr, it - I_IN, F.lane);
    }
    for (int m = gw; m < M; m += NGW) rms_row_to_bf16(F.x + (size_t)m * D, F.g_pre, F.H + (size_t)m * D, F.lane);
}

__device__ __forceinline__ void p2_norms(Frame& F) {
    const int gw = F.vcu * NWAVES + F.wave, NGW = F.G * NWAVES, lane = F.lane;
    for (int m = gw; m < M; m += NGW) {
        const bf16* pr = F.P + (size_t)m * NINP;
        const unsigned long long cv = *(const GAS unsigned long long*)(pr + C_CKV + 4 * lane);
        const float c0 = bflo((unsigned)cv), c1 = bfhi((unsigned)cv), c2 = bflo((unsigned)(cv >> 32)), c3 = bfhi((unsigned)(cv >> 32));
        const float kv = bf2f(pr[C_IK + lane]);
        const float sc = wave_sum((c0 * c0 + c1 * c1) + (c2 * c2 + c3 * c3)), sk = wave_sum(kv * kv);
        const float rc = rsqrtf(sc * (1.f / 256.f) + EPS), rk = rsqrtf(sk * (1.f / 64.f) + EPS);
        const f32x4 g = *((const GAS f32x4*)F.kvn_g + lane);
        *((GAS unsigned long long*)(F.CKVn + (size_t)m * 256) + lane) = (unsigned long long)pk2(c0 * rc * g.x, c1 * rc * g.y) | ((unsigned long long)pk2(c2 * rc * g.z, c3 * rc * g.w) << 32);
        F.IKn[(size_t)m * 64 + lane] = (bf16)f2bf(kv * rk * F.ikn_g[lane]);
    }
}

__device__ __forceinline__ void naive_diff_attn(Frame& F, int b, int h, int t, float lam, LAS float* L1, LAS float* L2, LAS float* qs) {
    const int lane = F.lane; const size_t row = (size_t)b * T + t;
    const bf16* Prow = F.P + row * NINP;
    qs[lane] = bf2f(Prow[C_QA + h * 64 + lane]); qs[64 + lane] = bf2f(Prow[C_QA + 512 + h * 64 + lane]);
    float m1 = -INFINITY, m2 = -INFINITY;
    for (int s0 = 0; s0 <= t; s0 += 64) { const int s = s0 + lane;
        if (s <= t) {
            const bf16* kr = F.P + ((size_t)b * T + s) * NINP + C_KA + h * 64;
            float a1 = 0.f, a2 = 0.f;
#pragma unroll
            for (int c = 0; c < 8; ++c) { const v4u k1 = *(const GAS v4u*)(kr + 8 * c), k2 = *(const GAS v4u*)(kr + 512 + 8 * c);
                const LAS float* q1 = qs + 8 * c; const LAS float* q2 = qs + 64 + 8 * c;
                a1 += q1[0] * bflo(k1.x) + q1[1] * bfhi(k1.x) + q1[2] * bflo(k1.y) + q1[3] * bfhi(k1.y) + q1[4] * bflo(k1.z) + q1[5] * bfhi(k1.z) + q1[6] * bflo(k1.w) + q1[7] * bfhi(k1.w);
                a2 += q2[0] * bflo(k2.x) + q2[1] * bfhi(k2.x) + q2[2] * bflo(k2.y) + q2[3] * bfhi(k2.y) + q2[4] * bflo(k2.z) + q2[5] * bfhi(k2.z) + q2[6] * bflo(k2.w) + q2[7] * bfhi(k2.w); }
            const float bias = F.rel_bias[t5_bucket(t - s) * 16 + h];
            a1 = a1 * 0.125f + bias; a2 = a2 * 0.125f + bias;
            L1[s] = a1; L2[s] = a2; m1 = fmaxf(m1, a1); m2 = fmaxf(m2, a2);
        } }
    m1 = wave_max(m1); m2 = wave_max(m2);
    float s1 = 0.f, s2 = 0.f;
    for (int s = lane; s <= t; s += 64) { const float e1 = __expf(L1[s] - m1), e2 = __expf(L2[s] - m2); L1[s] = e1; L2[s] = e2; s1 += e1; s2 += e2; }
    s1 = wave_sum(s1); s2 = wave_sum(s2);
    const float i1 = 1.f / s1, i2 = lam / s2;
    for (int s = lane; s <= t; s += 64) L1[s] = L1[s] * i1 - L2[s] * i2;
    float o0 = 0.f, o1 = 0.f; const bf16* vb = F.P + (size_t)b * T * NINP + C_VA + h * 128 + 2 * lane;
    for (int s = 0; s <= t; ++s) { const float a = L1[s]; const unsigned vv = *(const GAS unsigned*)(vb + (size_t)s * NINP); o0 += a * bflo(vv); o1 += a * bfhi(vv); }
    const float ss = wave_sum(o0 * o0 + o1 * o1); const float rs = rsqrtf(ss * (1.f / 128.f) + EPS) * 0.8f;
    const unsigned zz = *(const GAS unsigned*)(Prow + C_ZA + h * 128 + 2 * lane);
    const float r0 = o0 * rs * F.subln_g[2 * lane] * silu(bflo(zz)), r1 = o1 * rs * F.subln_g[2 * lane + 1] * silu(bfhi(zz));
    *(GAS unsigned*)(F.O + row * DO + h * 128 + 2 * lane) = pk2(r0, r1);
}

__device__ __forceinline__ unsigned skey(float f) { const unsigned u = __float_as_uint(f); return (u & 0x80000000u) ? ~u : (u | 0x80000000u); }
__device__ __forceinline__ void naive_dsa(Frame& F, int b, int t, LAS unsigned char* wl) {
    LAS float* S = (LAS float*)wl; LAS float* IQ = (LAS float*)(wl + 8192); LAS float* QH = (LAS float*)(wl + 12288); LAS float* PP = (LAS float*)(wl + 13312);
    LAS int* SEL = (LAS int*)(wl + 14336); LAS float* OL = (LAS float*)(wl + 15360);
    const int lane = F.lane; const size_t row = (size_t)b * T + t; const bf16* Prow = F.P + row * NINP;
    for (int i = lane; i < 1024; i += 64) IQ[i] = bf2f(Prow[C_IQ + i]);
    float w[16];
#pragma unroll
    for (int hh = 0; hh < 16; ++hh) w[hh] = bf2f(Prow[C_IW + hh]) * 0.25f;
    for (int s0 = 0; s0 <= t; s0 += 64) { const int s = s0 + lane;
        if (s <= t) {
            const bf16* kr = F.IKn + ((size_t)b * T + s) * 64;
            float acc[16];
#pragma unroll
            for (int hh = 0; hh < 16; ++hh) acc[hh] = 0.f;
#pragma unroll
            for (int c = 0; c < 8; ++c) { const v4u kk = *(const GAS v4u*)(kr + 8 * c);
                const float k0 = bflo(kk.x), k1 = bfhi(kk.x), k2 = bflo(kk.y), k3 = bfhi(kk.y), k4 = bflo(kk.z), k5 = bfhi(kk.z), k6 = bflo(kk.w), k7 = bfhi(kk.w);
#pragma unroll
                for (int hh = 0; hh < 16; ++hh) { const LAS float* q = IQ + hh * 64 + 8 * c;
                    acc[hh] += q[0] * k0 + q[1] * k1 + q[2] * k2 + q[3] * k3 + q[4] * k4 + q[5] * k5 + q[6] * k6 + q[7] * k7; } }
            float sc = 0.f;
#pragma unroll
            for (int hh = 0; hh < 16; ++hh) sc += w[hh] * fmaxf(acc[hh] * 0.125f, 0.f);
            S[s] = sc;
        } }
    const int n = t + 1; int nsel;
    if (n <= TOPK) { for (int i = lane; i < n; i += 64) SEL[i] = i; nsel = n; }
    else {
        unsigned thr = 0u;
        for (int bit = 31; bit >= 0; --bit) { const unsigned cand = thr | (1u << bit); int cnt = 0;
            for (int s0 = 0; s0 < n; s0 += 64) { const int s = s0 + lane; const bool ge = (s < n) && (skey(S[s]) >= cand); cnt += __popcll(__ballot(ge)); }
            if (cnt >= TOPK) thr = cand; }
        int cgt = 0;
        for (int s0 = 0; s0 < n; s0 += 64) { const int s = s0 + lane; const bool gt = (s < n) && (skey(S[s]) > thr); cgt += __popcll(__ballot(gt)); }
        const int need = TOPK - cgt; int pos = 0, eqseen = 0; const unsigned long long lt = (1ull << lane) - 1ull;
        for (int s0 = 0; s0 < n; s0 += 64) { const int s = s0 + lane; const bool valid = s < n; const unsigned k = valid ? skey(S[s]) : 0u;
            const bool gt = valid && k > thr, eq = valid && k == thr; const unsigned long long meq = __ballot(eq);
            const bool take = gt || (eq && (eqseen + __popcll(meq & lt)) < need); const unsigned long long mt = __ballot(take);
            if (take) SEL[pos + __popcll(mt & lt)] = s;
            pos += __popcll(mt); eqseen += __popcll(meq); }
        nsel = pos;
    }
    for (int h = 0; h < 8; ++h) {
#pragma unroll
        for (int i = 0; i < 4; ++i) QH[lane + 64 * i] = bf2f(Prow[C_QB + h * 256 + lane + 64 * i]);
        float lg[4]; float mx = -INFINITY;
#pragma unroll
        for (int i = 0; i < 4; ++i) { const int k = lane + 64 * i; lg[i] = -INFINITY;
            if (k < nsel) { const int s = SEL[k]; const bf16* cr = F.CKVn + ((size_t)b * T + s) * 256; float a = 0.f;
                for (int c = 0; c < 32; ++c) { const v4u kk = *(const GAS v4u*)(cr + 8 * c); const LAS float* q = QH + 8 * c;
                    a += q[0] * bflo(kk.x) + q[1] * bfhi(kk.x) + q[2] * bflo(kk.y) + q[3] * bfhi(kk.y) + q[4] * bflo(kk.z) + q[5] * bfhi(kk.z) + q[6] * bflo(kk.w) + q[7] * bfhi(kk.w); }
                lg[i] = a * 0.0625f + F.rel_bias[t5_bucket(t - s) * 16 + 8 + h]; mx = fmaxf(mx, lg[i]); } }
        mx = wave_max(mx); float sm = 0.f;
#pragma unroll
        for (int i = 0; i < 4; ++i) { lg[i] = (lane + 64 * i < nsel) ? __expf(lg[i] - mx) : 0.f; sm += lg[i]; }
        sm = wave_sum(sm); const float inv = 1.f / sm;
#pragma unroll
        for (int i = 0; i < 4; ++i) PP[lane + 64 * i] = lg[i] * inv;
        float o0 = 0.f, o1 = 0.f, o2 = 0.f, o3 = 0.f;
        for (int k = 0; k < nsel; ++k) { const int s = SEL[k]; const float p = PP[k];
            const unsigned long long cv = *(const GAS unsigned long long*)(F.CKVn + ((size_t)b * T + s) * 256 + 4 * lane);
            o0 += p * bflo((unsigned)cv); o1 += p * bfhi((unsigned)cv); o2 += p * bflo((unsigned)(cv >> 32)); o3 += p * bfhi((unsigned)(cv >> 32)); }
        OL[4 * lane] = o0; OL[4 * lane + 1] = o1; OL[4 * lane + 2] = o2; OL[4 * lane + 3] = o3;
        float a0 = 0.f, a1 = 0.f; const float* wu = F.w_uv + (size_t)h * 256 * 128 + 2 * lane;
        for (int c = 0; c < 256; ++c) { const float o = OL[c]; const float2 ww = *(const float2*)(wu + c * 128); a0 += o * ww.x; a1 += o * ww.y; }
        const unsigned zz = *(const GAS unsigned*)(Prow + C_ZB + h * 128 + 2 * lane);
        *(GAS unsigned*)(F.O + row * DO + 1024 + h * 128 + 2 * lane) = pk2(a0 * silu(bflo(zz)), a1 * silu(bfhi(zz)));
    }
}

__device__ __forceinline__ void p3_attention_naive(Frame& F) {
    const int gw = F.vcu * NWAVES + F.wave, NGW = F.G * NWAVES, lane = F.lane;
    LAS unsigned char* wl = F.lds + RING_OFF + F.wave * 16384;
    float d1 = F.lq1[lane] * F.lk1[lane], d2 = F.lq2[lane] * F.lk2[lane];
    const float lam = __expf(wave_sum(d1)) - __expf(wave_sum(d2)) + 0.2f;
    for (int task = gw; task < M; task += NGW) { const int b = task / T, tt = task % T; const int t = (b & 1) ? (T - 1 - tt) : tt; naive_dsa(F, b, t, wl); }
    LAS float* qs = (LAS float*)(F.lds + UP_OFF + F.wave * 512);
    for (int task = gw; task < M * 8; task += NGW) { const int bh = task / T, tt = task % T; const int t = (bh & 1) ? (T - 1 - tt) : tt;
        naive_diff_attn(F, bh >> 3, bh & 7, t, lam, (LAS float*)wl, (LAS float*)(wl + 8192), qs); }
}

__device__ __forceinline__ void p5_final(Frame& F) {
    const int gw = F.vcu * NWAVES + F.wave, NGW = F.G * NWAVES, lane = F.lane;
    for (int m = gw; m < M; m += NGW) {
        const GAS v4u* yr = (const GAS v4u*)(F.Y + (size_t)m * D) + lane; v4u y[4]; float s = 0.f;
#pragma unroll
        for (int j = 0; j < 4; ++j) { y[j] = yr[64 * j];
            const float a0 = bflo(y[j].x), a1 = bfhi(y[j].x), a2 = bflo(y[j].y), a3 = bfhi(y[j].y), a4 = bflo(y[j].z), a5 = bfhi(y[j].z), a6 = bflo(y[j].w), a7 = bfhi(y[j].w);
            s += (a0 * a0 + a1 * a1) + (a2 * a2 + a3 * a3) + (a4 * a4 + a5 * a5) + (a6 * a6 + a7 * a7); }
        const float rstd = rsqrtf(wave_sum(s) * (1.f / D) + EPS);
#pragma unroll
        for (int j = 0; j < 4; ++j) { const size_t e = (size_t)(64 * j + lane) * 8;
            const f32x4 x0 = *(const GAS f32x4*)(F.x + (size_t)m * D + e), x1 = *(const GAS f32x4*)(F.x + (size_t)m * D + e + 4);
            const f32x4 g0 = *(const GAS f32x4*)(F.g_post + e), g1 = *(const GAS f32x4*)(F.g_post + e + 4);
            f32x4 r0, r1;
            r0.x = x0.x + bflo(y[j].x) * rstd * g0.x; r0.y = x0.y + bfhi(y[j].x) * rstd * g0.y; r0.z = x0.z + bflo(y[j].y) * rstd * g0.z; r0.w = x0.w + bfhi(y[j].y) * rstd * g0.w;
            r1.x = x1.x + bflo(y[j].z) * rstd * g1.x; r1.y = x1.y + bfhi(y[j].z) * rstd * g1.y; r1.z = x1.z + bflo(y[j].w) * rstd * g1.z; r1.w = x1.w + bfhi(y[j].w) * rstd * g1.w;
            *(GAS f32x4*)(F.out + (size_t)m * D + e) = r0; *(GAS f32x4*)(F.out + (size_t)m * D + e + 4) = r1; }
    }
}

struct Args { const float* in[14]; float* out; unsigned char* ws; int ph_lo, ph_hi, li, pad; };
__global__ void __launch_bounds__(NWAVES * 64, 2) fwd(Args args) {
    extern __shared__ __attribute__((aligned(16))) unsigned char lds[];
    Frame F;
    F.lds = (LAS unsigned char*)lds;
    F.MISC = (volatile LAS unsigned*)(F.lds + MISC_OFF);
    F.tid = threadIdx.x; F.lane = F.tid & 63; F.wave = __builtin_amdgcn_readfirstlane(F.tid >> 6);
    F.G = gridDim.x; { const int bx = blockIdx.x; F.vcu = (F.G % 8 == 0) ? (bx % 8) * (F.G / 8) + bx / 8 : bx; }
    unsigned char* ws = args.ws;
    F.ctl = (gu32*)(ws + WS_CTL);
    F.x = args.in[0]; F.g_pre = args.in[1]; F.w_in = args.in[2]; F.lq1 = args.in[3]; F.lk1 = args.in[4]; F.lq2 = args.in[5]; F.lk2 = args.in[6]; F.subln_g = args.in[7];
    F.kvn_g = args.in[8]; F.ikn_g = args.in[9]; F.w_uv = args.in[10]; F.rel_bias = args.in[11]; F.w_out = args.in[12]; F.g_post = args.in[13]; F.out = args.out;
    F.WinT = (bf16*)(ws + WS_WIN); F.WoutT = (bf16*)(ws + WS_WOUT); F.WuvT = (bf16*)(ws + WS_WUV); F.CKVn = (bf16*)(ws + WS_CKV); F.IKn = (bf16*)(ws + WS_IK);
    F.H = (bf16*)(ws + WS_H); F.O = (bf16*)(ws + WS_H); F.P = (bf16*)(ws + WS_P); F.Y = (bf16*)(ws + WS_P);
    for (int u = F.tid; u < (LDS_BYTES - LDSCTL_OFF) / 4; u += NWAVES * 64) ((LAS unsigned*)(F.lds + LDSCTL_OFF))[u] = 0u;
    __syncthreads();
    XcdBarrier bar; bar.bar = (unsigned*)(F.ctl + CW_BAR); bar.x = 0; bar.st = nullptr;
    if (N_LAUNCHES != PER_PHASE) bar = xcd_barrier_post((unsigned*)(F.ctl + CW_BAR), F.MISC + 8);
#define GRID_BAR(seam) do { if (N_LAUNCHES == PER_PHASE) { if (F.tid == 0) __hip_atomic_store(F.ctl + CW_TMO, 0xBADBA0u | (unsigned)(seam), RLX_AGENT); } else { xcd_barrier(bar); } } while (0)
    const int lo = args.ph_lo, hi = args.ph_hi;
#define IN(k) (lo <= (k) && (k) < hi)
#define BOTH(k) (IN(k) && IN((k) + 1))

    if (IN(0)) { p0_prologue(F); if (BOTH(0)) GRID_BAR(0); }

    if (IN(1)) {
        pg8::Gemm g{F.H, F.WinT, M, NINP, D}; pg8::StaticOrder S; S.init(M, NINP, F.G, (int)blockIdx.x);
        pg8::EpiBf16<0> E{F.P, NINP, nullptr, 0, 0, 1.f};
        pg8::gemm_phase<pg8::EpiBf16<0>, pg8::StaticOrder, PG8_ALIGN, PG8_SP2>(F.lds + RING_OFF, g, S, E);
        if (BOTH(1)) GRID_BAR(1);
    }

    if (IN(2)) { p2_norms(F); if (BOTH(2)) GRID_BAR(2); }

    if (IN(3)) { p3_attention_naive(F); if (BOTH(3)) GRID_BAR(3); }

    if (IN(4)) {
        pg8::Gemm g{F.O, F.WoutT, M, D, DO}; pg8::StaticOrder S; S.init(M, D, F.G, (int)blockIdx.x);
        pg8::EpiBf16<0> E{F.Y, D, nullptr, 0, 0, 1.f};
        pg8::gemm_phase<pg8::EpiBf16<0>, pg8::StaticOrder, PG8_ALIGN, PG8_SP2>(F.lds + RING_OFF, g, S, E);
        if (BOTH(4)) GRID_BAR(4);
    }

    if (IN(5)) { p5_final(F); }
#undef IN
#undef BOTH
}

extern "C" void kernel_launch(void* const* d_in, const int* in_sizes, int n_in, void* d_out, int out_size, void* d_ws, size_t ws_size, hipStream_t stream) {
    static int grid = 0;
    if (grid == 0) {
        if (n_in != 14 || in_sizes[0] != M * D || out_size != M * D || ws_size < WS_END) { fprintf(stderr, "kernel_launch: unexpected shapes (n_in %d, in0 %d, out %d, ws %zu); nothing launched\n", n_in, n_in > 0 ? in_sizes[0] : -1, out_size, ws_size); grid = -1; return; }
        int dev = 0, cus = 0, per_cu = 0;
        if (hipGetDevice(&dev) != hipSuccess || hipDeviceGetAttribute(&cus, hipDeviceAttributeMultiprocessorCount, dev) != hipSuccess) { grid = -1; return; }
        if (hipFuncSetAttribute((const void*)fwd, hipFuncAttributeMaxDynamicSharedMemorySize, LDS_BYTES) != hipSuccess) { fprintf(stderr, "kernel_launch: hipFuncSetAttribute failed\n"); grid = -1; return; }
        if (hipOccupancyMaxActiveBlocksPerMultiprocessor(&per_cu, (const void*)fwd, NWAVES * 64, LDS_BYTES) != hipSuccess || per_cu < 1)
            fprintf(stderr, "kernel_launch: note: occupancy query reports %d workgroups per CU\n", per_cu);
        (void)hipGetLastError();
        grid = cus;
    }
    if (grid < 0) return;
    if (hipMemsetAsync((char*)d_ws + WS_CTL, 0, CTL_ZERO_BYTES, stream) != hipSuccess) return;
    Args a{};
    for (int i = 0; i < 14; ++i) a.in[i] = (const float*)d_in[i];
    a.out = (float*)d_out; a.ws = (unsigned char*)d_ws;
    for (int li = 0; li < N_LAUNCHES; ++li) {
        a.ph_lo = (N_LAUNCHES == PER_PHASE) ? li : 0; a.ph_hi = (N_LAUNCHES == PER_PHASE) ? li + 1 : PER_PHASE; a.li = li;
        hipLaunchKernelGGL(fwd, dim3(grid), dim3(NWAVES * 64), LDS_BYTES, stream, a);
        const hipError_t le = hipPeekAtLastError();
        if (le != hipSuccess) { fprintf(stderr, "kernel_launch: launch %d failed: %s\n", li, hipGetErrorName(le)); break; }
    }
}
```

```cpp
#include <hip/hip_runtime.h>
#include <cstdio>
#include <cstdint>
namespace pg8 {
#define PG8_LAS __attribute__((address_space(3)))
typedef unsigned short bf16_t;
typedef short bf16x8 __attribute__((ext_vector_type(8)));
typedef float f32x4 __attribute__((ext_vector_type(4)));
typedef unsigned u32x4 __attribute__((ext_vector_type(4)));
constexpr int BM = 256, BK = 64, HALF = 128, HTB = HALF * BK * 2  , STAGE_BYTES = 8 * HTB, NXCD = 8, WGM = 8;

__host__ __device__ __forceinline__ int lds_byte(int r, int c) { const int st = (r >> 4) * 2 + (c >> 5), rr = r & 15, cc = c & 31, ob = rr * 64 + cc * 2; return st * 1024 + (ob ^ (((ob >> 9) & 1) << 5)); }
__host__ __device__ __forceinline__ void stage_rc(int b, int& R, int& C) { const int st = b / 1024, sb = b % 1024, swz = sb ^ (((sb >> 9) & 1) << 5); R = (st >> 1) * 16 + swz / 64; C = (st & 1) * 32 + (swz % 64) / 2; }
__host__ __device__ __forceinline__ int perm32(int rho) { const int n = rho >> 4, i = rho & 15; return 8 * (i >> 2) + 4 * n + (i & 3); }

struct Unit { int pm, pn; };
struct Gemm { const bf16_t* A; const bf16_t* Bt; int M, N, K; };

struct StaticOrder {
    int nM, nN, nwg, G, c;
    __host__ __device__ void init(int M, int N, int G_, int c_) { nM = M / BM; nN = N / BM; nwg = nM * nN; G = G_; c = c_; }
    __host__ __device__ bool next(int i, Unit& u) const {
        const long L = (long)i * G + c; if (L >= nwg) return false;
        int wgid = (int)L; { const int q = nwg / NXCD, r = nwg % NXCD, xcd = wgid % NXCD, off = wgid / NXCD; wgid = (xcd < r ? xcd * (q + 1) : r * (q + 1) + (xcd - r) * q) + off; }
        const int nig = WGM * nN, gid = wgid / nig, fm = gid * WGM, gsz = (nM - fm) < WGM ? (nM - fm) : WGM;
        u.pm = fm + ((wgid % nig) % gsz); u.pn = (wgid % nig) / gsz; return true;
    }
    __device__ __forceinline__ void a_ready(const Unit&) const {}
    __device__ __forceinline__ void done(const Unit&) const {}
};

__device__ __forceinline__ unsigned cvt_pk_bf16(float lo, float hi) { unsigned r; asm volatile("v_cvt_pk_bf16_f32 %0, %1, %2" : "=v"(r) : "v"(lo), "v"(hi)); return r; }
typedef float f32x2 __attribute__((ext_vector_type(2)));
__device__ __forceinline__ f32x2 gelu_pk(f32x2 v) {
    const f32x2 av = __builtin_elementwise_abs(v), d = av * 0.2316418882f + 1.0f;
    f32x2 t; t.x = __builtin_amdgcn_rcpf(d.x); t.y = __builtin_amdgcn_rcpf(d.y);
    f32x2 q = t * 0.5307027145f + (-0.7265760135f); q = q * t + 0.7107068705f; q = q * t + (-0.142248368f); q = q * t + 0.127414796f; q = q * t;
    const f32x2 s = (v * v) * (-0.72134752044f);
    f32x2 e; e.x = __builtin_amdgcn_exp2f(s.x); e.y = __builtin_amdgcn_exp2f(s.y);
    const f32x2 m = v * (q * e), r = v - m;
    f32x2 o; o.x = v.x < 0.f ? m.x : r.x; o.y = v.y < 0.f ? m.y : r.y; return o;
}

template <int ACT  > struct EpiBf16 {
    static constexpr bool PERM = true, AFTER_DRAIN = false; static_assert(ACT == 0 || ACT == 1, "EpiBf16: ACT is 0 (none) or 1 (gelu_pk)");
    bf16_t* O; int ldc; const float* bias; int split_cols; size_t split_stride; float scale0;
    __device__ __forceinline__ void operator()(const f32x4 (&acc)[2][2][4][2], const Unit& u, int wr, int wc, int fr, int fq) const {
        const int row0 = u.pm * BM + wr * 64 + fr; int colt = u.pn * BM; bf16_t* base = O;
        float sc = 1.f; if (split_cols) { const int t = colt / split_cols; base += (size_t)t * split_stride; colt -= t * split_cols; if (t == 0) sc = scale0; }
        const int col0 = colt + wc * 32 + 8 * fq, bcol0 = u.pn * BM + wc * 32 + 8 * fq;
        f32x4 bv[2][2];
#pragma unroll
        for (int bj = 0; bj < 2; ++bj)
#pragma unroll
            for (int n = 0; n < 2; ++n) bv[bj][n] = bias ? *(const f32x4*)(bias + bcol0 + bj * HALF + 4 * n) : (f32x4){0.f, 0.f, 0.f, 0.f};
#pragma unroll
        for (int ai = 0; ai < 2; ++ai)
#pragma unroll
            for (int m = 0; m < 4; ++m) { bf16_t* rowp = base + (size_t)(row0 + ai * HALF + m * 16) * ldc + col0;
#pragma unroll
                for (int bj = 0; bj < 2; ++bj) { f32x4 v0 = acc[ai][bj][m][0] + bv[bj][0], v1 = acc[ai][bj][m][1] + bv[bj][1];
                    if (ACT == 1) { f32x2 a = gelu_pk((f32x2){v0[0], v0[1]}), b = gelu_pk((f32x2){v0[2], v0[3]}), c = gelu_pk((f32x2){v1[0], v1[1]}), d = gelu_pk((f32x2){v1[2], v1[3]});
                        v0 = (f32x4){a.x, a.y, b.x, b.y}; v1 = (f32x4){c.x, c.y, d.x, d.y}; }
                    v0 = v0 * sc; v1 = v1 * sc; u32x4 w; w.x = cvt_pk_bf16(v0[0], v0[1]); w.y = cvt_pk_bf16(v0[2], v0[3]); w.z = cvt_pk_bf16(v1[0], v1[1]); w.w = cvt_pk_bf16(v1[2], v1[3]);
                    __builtin_nontemporal_store(w, (u32x4*)(rowp + bj * HALF)); } }
    }
};

struct PanelStats {
    unsigned* xbuf;
    unsigned* cnt;
    unsigned* tmo;
    int ntn; float eps;
    unsigned code;
    __device__ __forceinline__ bool run(const f32x4 (&v)[2][2][4][2], const Unit& u, int wr, int wc, int fr, int fq, PG8_LAS unsigned char* lds, int wid, int lane) const {
        typedef float f32x2v __attribute__((ext_vector_type(2)));
        PG8_LAS f32x2v* P = (PG8_LAS f32x2v*)lds;
        PG8_LAS f32x2v* S = (PG8_LAS f32x2v*)(lds + 8192);
        PG8_LAS unsigned* flag = (PG8_LAS unsigned*)(lds + 8192 + 2048);
#pragma unroll
        for (int ai = 0; ai < 2; ++ai)
#pragma unroll
            for (int m = 0; m < 4; ++m) {
                float s = 0.f;
#pragma unroll
                for (int bj = 0; bj < 2; ++bj)
#pragma unroll
                    for (int n = 0; n < 2; ++n) { const f32x4 x = v[ai][bj][m][n]; s += (x[0] + x[1]) + (x[2] + x[3]); }
                s += __shfl_xor(s, 16); s += __shfl_xor(s, 32);
                const float mw = s * (1.0f / 64.0f); float q = 0.f;
#pragma unroll
                for (int bj = 0; bj < 2; ++bj)
#pragma unroll
                    for (int n = 0; n < 2; ++n) { const f32x4 d = v[ai][bj][m][n] - mw; q += (d[0] * d[0] + d[1] * d[1]) + (d[2] * d[2] + d[3] * d[3]); }
                q += __shfl_xor(q, 16); q += __shfl_xor(q, 32);
                if (fq == 0) P[(ai * HALF + wr * 64 + m * 16 + fr) * 4 + wc] = (f32x2v){mw, q};
            }
        asm volatile("s_waitcnt lgkmcnt(0)" ::: "memory"); __builtin_amdgcn_s_barrier(); asm volatile("" ::: "memory");
#if defined(BROKEN_EXCHANGE_NO_WAIT)
#warning BROKEN CONTROL BUILD: the row-statistics exchange does not wait; results are wrong by design
        if (blockIdx.x >= 64) { const long long t0_ = clock64(); while (clock64() - t0_ < 60000) __builtin_amdgcn_s_sleep(8); }
#endif
        const int row = wid * 32 + (lane & 31);
        if (lane < 32) {
            const f32x2v a = P[row * 4 + 0], b = P[row * 4 + 1], c = P[row * 4 + 2], d = P[row * 4 + 3];
            const float mt = (a.x + b.x + c.x + d.x) * 0.25f;
            const float da = a.x - mt, db = b.x - mt, dc = c.x - mt, dd = d.x - mt;
            const float m2 = (a.y + b.y) + (c.y + d.y) + 64.0f * ((da * da + db * db) + (dc * dc + dd * dd));
            unsigned long long* slot = (unsigned long long*)xbuf + ((size_t)(u.pm * BM + row) * 4 + u.pn);
            __hip_atomic_store(slot, ((unsigned long long)__float_as_uint(m2) << 32) | __float_as_uint(mt), __ATOMIC_RELAXED, __HIP_MEMORY_SCOPE_AGENT);
        }
        asm volatile("s_waitcnt vmcnt(0)" ::: "memory");
        if (lane == 0) __hip_atomic_fetch_add(cnt + 64 * u.pm, 1u, __ATOMIC_RELAXED, __HIP_MEMORY_SCOPE_AGENT);
        if (wid == 0) {
            bool dead = false; const unsigned long long t0 = __builtin_amdgcn_s_memrealtime(); const unsigned want = 8u * (unsigned)ntn;
            for (;;) {
#if defined(BROKEN_EXCHANGE_NO_WAIT)
                break;
#endif
                if ((unsigned)__builtin_amdgcn_readfirstlane(__hip_atomic_load(cnt + 64 * u.pm, __ATOMIC_RELAXED, __HIP_MEMORY_SCOPE_AGENT)) >= want) break;
                if (__builtin_amdgcn_s_memrealtime() - t0 > 2000000ull) {
                    if (lane == 0) { unsigned expect = 0u; __hip_atomic_compare_exchange_strong(tmo + 1, &expect, code | (unsigned)(u.pm & 0xff), __ATOMIC_RELAXED, __ATOMIC_RELAXED, __HIP_MEMORY_SCOPE_AGENT);
                                     __hip_atomic_store(tmo, 1u, __ATOMIC_RELAXED, __HIP_MEMORY_SCOPE_AGENT); }
                    dead = true; break; }
                __builtin_amdgcn_s_sleep(2);
            }
            __builtin_amdgcn_fence(__ATOMIC_ACQUIRE, "agent");
            if (lane == 0) flag[0] = dead ? 1u : 0u;
        }
        asm volatile("s_waitcnt vmcnt(0) lgkmcnt(0)" ::: "memory"); __builtin_amdgcn_s_barrier(); asm volatile("" ::: "memory");
        const bool bad = flag[0] != 0u;
        if (lane < 32) {
            const unsigned long long* slot = (const unsigned long long*)xbuf + (size_t)(u.pm * BM + row) * 4; float mt[4], m2[4]; float ms = 0.f;
#pragma unroll
            for (int t = 0; t < 4; ++t) { if (t < ntn) { const unsigned long long w = __hip_atomic_load(slot + t, __ATOMIC_RELAXED, __HIP_MEMORY_SCOPE_AGENT); mt[t] = __uint_as_float((unsigned)w); m2[t] = __uint_as_float((unsigned)(w >> 32)); } else { mt[t] = 0.f; m2[t] = 0.f; } ms += mt[t]; }
            const float mean = ms / (float)ntn; float q = 0.f;
#pragma unroll
            for (int t = 0; t < 4; ++t) if (t < ntn) { const float dm = mt[t] - mean; q += m2[t] + 256.0f * dm * dm; }
            S[row] = (f32x2v){mean, 1.0f / sqrtf(q / (256.0f * (float)ntn) + eps)};
        }
        asm volatile("s_waitcnt lgkmcnt(0)" ::: "memory"); __builtin_amdgcn_s_barrier(); asm volatile("" ::: "memory");
        return bad;
    }
};
struct EpiLnRes {
    static constexpr bool PERM = false, AFTER_DRAIN = true;
    const float* base; float* out; int ldc; const float* bias; PanelStats st; unsigned poison;
    __device__ __forceinline__ void fused(f32x4 (&acc)[2][2][4][2], const Unit& u, int wr, int wc, int fr, int fq, PG8_LAS unsigned char* lds, int wid, int lane) const {
        typedef float f32x2v __attribute__((ext_vector_type(2)));
        const PG8_LAS f32x2v* S = (const PG8_LAS f32x2v*)(lds + 8192);
        const int col0 = u.pn * BM + wc * 32 + 4 * fq;
#pragma unroll
        for (int bj = 0; bj < 2; ++bj)
#pragma unroll
            for (int n = 0; n < 2; ++n) { const f32x4 bv = bias ? *(const f32x4*)(bias + col0 + bj * HALF + n * 16) : (f32x4){0.f, 0.f, 0.f, 0.f};
#pragma unroll
                for (int ai = 0; ai < 2; ++ai)
#pragma unroll
                    for (int m = 0; m < 4; ++m) acc[ai][bj][m][n] += bv; }
        f32x4 pre[4][2][2];
#pragma unroll
        for (int m = 0; m < 4; ++m) { const size_t off = (size_t)(u.pm * BM + wr * 64 + m * 16 + fr) * ldc + col0;
#pragma unroll
            for (int bj = 0; bj < 2; ++bj)
#pragma unroll
                for (int n = 0; n < 2; ++n) pre[m][bj][n] = *(const f32x4*)(base + off + bj * HALF + n * 16); }
        const bool bad = st.run(acc, u, wr, wc, fr, fq, lds, wid, lane) || poison != 0u;
        const float qnan = __builtin_nanf("");
#pragma unroll
        for (int ai = 0; ai < 2; ++ai)
#pragma unroll
            for (int m = 0; m < 4; ++m) { const int r = ai * HALF + wr * 64 + m * 16 + fr; const f32x2v sr = S[r]; const size_t off = (size_t)(u.pm * BM + r) * ldc + col0;
#pragma unroll
                for (int bj = 0; bj < 2; ++bj)
#pragma unroll
                    for (int n = 0; n < 2; ++n) { const f32x4 bs = ai == 0 ? pre[m][bj][n] : *(const f32x4*)(base + off + bj * HALF + n * 16); f32x4 o = bs + (acc[ai][bj][m][n] - sr.x) * sr.y;
                        if (bad) o = (f32x4){qnan, qnan, qnan, qnan}; *(f32x4*)(out + off + bj * HALF + n * 16) = o; }
                if (m & 1) asm volatile("" ::: "memory"); }
    }
};
struct EpiLnResLn {
    static constexpr bool PERM = false, AFTER_DRAIN = true;
    const float* base; float* out; bf16_t* xn; int ldc; const float* bias; PanelStats st1, st2; unsigned poison;
    __device__ __forceinline__ void fused(f32x4 (&acc)[2][2][4][2], const Unit& u, int wr, int wc, int fr, int fq, PG8_LAS unsigned char* lds, int wid, int lane) const {
        typedef float f32x2v __attribute__((ext_vector_type(2))); typedef unsigned u32x2v __attribute__((ext_vector_type(2)));
        const PG8_LAS f32x2v* S = (const PG8_LAS f32x2v*)(lds + 8192);
        const int col0 = u.pn * BM + wc * 32 + 4 * fq;
#pragma unroll
        for (int bj = 0; bj < 2; ++bj)
#pragma unroll
            for (int n = 0; n < 2; ++n) { const f32x4 bv = bias ? *(const f32x4*)(bias + col0 + bj * HALF + n * 16) : (f32x4){0.f, 0.f, 0.f, 0.f};
#pragma unroll
                for (int ai = 0; ai < 2; ++ai)
#pragma unroll
                    for (int m = 0; m < 4; ++m) acc[ai][bj][m][n] += bv; }
        bool bad = st1.run(acc, u, wr, wc, fr, fq, lds, wid, lane) || poison != 0u;
        const float qnan = __builtin_nanf("");
#pragma unroll
        for (int ai = 0; ai < 2; ++ai)
#pragma unroll
            for (int m = 0; m < 4; ++m) { const int r = ai * HALF + wr * 64 + m * 16 + fr; const f32x2v sr = S[r]; const size_t off = (size_t)(u.pm * BM + r) * ldc + col0;
#pragma unroll
                for (int bj = 0; bj < 2; ++bj)
#pragma unroll
                    for (int n = 0; n < 2; ++n) { const f32x4 bs = *(const f32x4*)(base + off + bj * HALF + n * 16); acc[ai][bj][m][n] = bs + (acc[ai][bj][m][n] - sr.x) * sr.y; }
                asm volatile("" : "+v"(acc[ai][0][m][0]), "+v"(acc[ai][0][m][1]), "+v"(acc[ai][1][m][0]), "+v"(acc[ai][1][m][1]));
                if (m & 1) asm volatile("" ::: "memory"); }
        const bool bad1 = bad;
        bad = st2.run(acc, u, wr, wc, fr, fq, lds, wid, lane) || bad;
#pragma unroll
        for (int ai = 0; ai < 2; ++ai)
#pragma unroll
            for (int m = 0; m < 4; ++m) { const int r = ai * HALF + wr * 64 + m * 16 + fr; const f32x2v sr = S[r]; const size_t off = (size_t)(u.pm * BM + r) * ldc + col0;
#pragma unroll
                for (int bj = 0; bj < 2; ++bj)
#pragma unroll
                    for (int n = 0; n < 2; ++n) { const f32x4 x1 = acc[ai][bj][m][n]; *(f32x4*)(out + off + bj * HALF + n * 16) = bad1 ? (f32x4){qnan, qnan, qnan, qnan} : x1;
                        const f32x4 o = (x1 - sr.x) * sr.y; u32x2v w; w.x = cvt_pk_bf16(o[0], o[1]); w.y = cvt_pk_bf16(o[2], o[3]);
                        if (bad) { w.x = 0x7fc07fc0u; w.y = 0x7fc07fc0u; } *(u32x2v*)(xn + off + bj * HALF + n * 16) = w; }
                asm volatile("" ::: "memory"); }
    }
};

template <class Epi, class Sched, bool ALIGN_EPI = false, bool SP2 = false>
__device__ __forceinline__ void gemm_phase(PG8_LAS unsigned char* lds, const Gemm g, const Sched& S, const Epi& E, int wid_in) {
    const int lane = (int)__builtin_amdgcn_mbcnt_hi(~0u, __builtin_amdgcn_mbcnt_lo(~0u, 0u)), wid = wid_in, tid = wid * 64 + lane, wr = wid >> 2, wc = wid & 3, fr = lane & 15, fq = lane >> 4;
    const int K = g.K, nt = K / BK;
    unsigned voffA[2], voffB[2];
#pragma unroll
    for (int i = 0; i < 2; ++i) { int R, C; stage_rc(tid * 16 + i * 8192, R, C); const int Rb = Epi::PERM ? ((R & ~31) + perm32(R & 31)) : R;
        voffA[i] = (unsigned)(R * K + C) * 2u; voffB[i] = (unsigned)(Rb * K + C) * 2u; }
    const size_t kstep = (size_t)(BK * 2);
    const size_t hstep = (size_t)HALF * K * 2;
    const size_t tstep = 2 * hstep;
    const unsigned ldsw = (unsigned)wid * 1024u;
    const int aoff = lds_byte(wr * 64 + fr, fq * 8), boff = lds_byte(wc * 32 + fr, fq * 8);
#define PG8_SA(b, h) (((b) * 2 + (h)) * HTB)
#define PG8_SB(b, h) ((4 + (b) * 2 + (h)) * HTB)
#define PG8_STAGE(bufoff, gbase, voff) do { _Pragma("unroll") for (int _i = 0; _i < 2; ++_i) \
        __builtin_amdgcn_global_load_lds((const unsigned*)((const char*)(gbase) + (voff)[_i]), (PG8_LAS unsigned*)(lds + (bufoff) + ldsw + _i * 8192), 16, 0, 0); } while (0)
#define PG8_LDA(dst, b, h) do { _Pragma("unroll") for (int m = 0; m < 4; ++m) _Pragma("unroll") for (int k = 0; k < 2; ++k) dst[m][k] = *(const PG8_LAS bf16x8*)(lds + PG8_SA(b, h) + aoff + m * 2048 + k * 1024); } while (0)
#define PG8_LDB(dst, b, h) do { _Pragma("unroll") for (int n = 0; n < 2; ++n) _Pragma("unroll") for (int k = 0; k < 2; ++k) dst[n][k] = *(const PG8_LAS bf16x8*)(lds + PG8_SB(b, h) + boff + n * 2048 + k * 1024); } while (0)
#define PG8_MMA(ai, bj, At, Bt) do { __builtin_amdgcn_s_setprio(1); _Pragma("unroll") for (int m = 0; m < 4; ++m) _Pragma("unroll") for (int n = 0; n < 2; ++n) _Pragma("unroll") for (int k = 0; k < 2; ++k) \
        acc[ai][bj][m][n] = __builtin_amdgcn_mfma_f32_16x16x32_bf16(Bt[n][k], At[m][k], acc[ai][bj][m][n], 0, 0, 0); __builtin_amdgcn_s_setprio(0); } while (0)
#define PG8_WAIT_V(n) asm volatile("s_waitcnt vmcnt(" #n ")" ::: "memory")
#define PG8_WAIT_L(n) asm volatile("s_waitcnt lgkmcnt(" #n ")" ::: "memory")
#define PG8_BAR __builtin_amdgcn_s_barrier()
#define PG8_SCHED __builtin_amdgcn_sched_barrier(0)
    Unit cur, nxt; int ui = 0;
    if (!S.next(0, cur)) return;
    f32x4 acc[2][2][4][2];
#pragma unroll
    for (int a = 0; a < 2; ++a)
#pragma unroll
        for (int b = 0; b < 2; ++b)
#pragma unroll
            for (int m = 0; m < 4; ++m)
#pragma unroll
                for (int n = 0; n < 2; ++n) acc[a][b][m][n] = (f32x4){0.f, 0.f, 0.f, 0.f};
    bf16x8 At[4][2], B0[2][2], B1[2][2];
    const char* cA = (const char*)g.A + (size_t)cur.pm * tstep; const char* cB = (const char*)g.Bt + (size_t)cur.pn * tstep;
    S.a_ready(cur);
    if constexpr (SP2) {
        PG8_STAGE(PG8_SB(0, 0), cB, voffB); PG8_STAGE(PG8_SB(0, 1), cB + hstep, voffB); PG8_STAGE(PG8_SA(0, 0), cA, voffA); PG8_STAGE(PG8_SA(0, 1), cA + hstep, voffA);
        if (wr == 1) PG8_BAR;
        PG8_WAIT_V(2); PG8_BAR;
        PG8_STAGE(PG8_SB(1, 0), cB + kstep, voffB); PG8_STAGE(PG8_SA(1, 0), cA + kstep, voffA); PG8_STAGE(PG8_SB(1, 1), cB + hstep + kstep, voffB);
        PG8_WAIT_V(6); PG8_BAR;
    } else {
        PG8_STAGE(PG8_SB(0, 0), cB, voffB); PG8_STAGE(PG8_SA(0, 0), cA, voffA); PG8_STAGE(PG8_SB(0, 1), cB + hstep, voffB); PG8_STAGE(PG8_SA(0, 1), cA + hstep, voffA);
        if (wr == 1) PG8_BAR;
        PG8_WAIT_V(4); PG8_BAR;
        PG8_STAGE(PG8_SB(1, 0), cB + kstep, voffB); PG8_STAGE(PG8_SA(1, 0), cA + kstep, voffA); PG8_STAGE(PG8_SB(1, 1), cB + hstep + kstep, voffB);
        PG8_WAIT_V(6); PG8_BAR;
    }
    for (;;) {
        const bool has_next = S.next(ui + 1, nxt);
        const char* nA = has_next ? (const char*)g.A + (size_t)nxt.pm * tstep : cA; const char* nB = has_next ? (const char*)g.Bt + (size_t)nxt.pn * tstep : cB;
        for (int t = 0; t < nt; t += 2) {
            const bool last = (t == nt - 2);
            const char* a1 = cA + (size_t)(t + 1) * kstep;
            const char* a2 = last ? nA : cA + (size_t)(t + 2) * kstep; const char* b2 = last ? nB : cB + (size_t)(t + 2) * kstep;
            const char* a3 = a2 + kstep; const char* b3 = b2 + kstep;
            if (last && has_next) S.a_ready(nxt);
            if constexpr (SP2) {
            PG8_LDB(B0, 0, 0); PG8_LDB(B1, 0, 1); PG8_SCHED; PG8_LDA(At, 0, 0); PG8_STAGE(PG8_SA(1, 1), a1 + hstep, voffA);
            PG8_WAIT_V(8); PG8_WAIT_L(0); PG8_BAR; PG8_MMA(0, 0, At, B0); PG8_MMA(0, 1, At, B1); PG8_BAR; PG8_SCHED;
            PG8_LDA(At, 0, 1); PG8_STAGE(PG8_SB(0, 0), b2, voffB); PG8_STAGE(PG8_SB(0, 1), b2 + hstep, voffB); PG8_STAGE(PG8_SA(0, 0), a2, voffA);
            PG8_WAIT_V(8); PG8_WAIT_L(0); PG8_BAR; PG8_MMA(1, 0, At, B0); PG8_MMA(1, 1, At, B1); PG8_BAR; PG8_SCHED;
            PG8_LDB(B0, 1, 0); PG8_LDB(B1, 1, 1); PG8_SCHED; PG8_LDA(At, 1, 0); PG8_STAGE(PG8_SA(0, 1), a2 + hstep, voffA);
            PG8_WAIT_V(8); PG8_WAIT_L(0); PG8_BAR; PG8_MMA(0, 0, At, B0); PG8_MMA(0, 1, At, B1); PG8_BAR; PG8_SCHED;
            PG8_LDA(At, 1, 1); PG8_STAGE(PG8_SB(1, 0), b3, voffB); PG8_STAGE(PG8_SB(1, 1), b3 + hstep, voffB); PG8_STAGE(PG8_SA(1, 0), a3, voffA);
            PG8_WAIT_V(8); PG8_WAIT_L(0); PG8_BAR; PG8_MMA(1, 0, At, B0); PG8_MMA(1, 1, At, B1); PG8_BAR; PG8_SCHED;
            } else {
            PG8_LDB(B0, 0, 0); PG8_SCHED; PG8_LDA(At, 0, 0); PG8_STAGE(PG8_SA(1, 1), a1 + hstep, voffA);
            PG8_WAIT_L(8); PG8_BAR; PG8_WAIT_L(0); PG8_MMA(0, 0, At, B0); PG8_BAR; PG8_SCHED;
            PG8_LDB(B1, 0, 1); PG8_STAGE(PG8_SB(0, 0), b2, voffB);
            PG8_BAR; PG8_WAIT_L(0); PG8_MMA(0, 1, At, B1); PG8_BAR;
            PG8_LDA(At, 0, 1); PG8_STAGE(PG8_SA(0, 0), a2, voffA);
            PG8_BAR; PG8_WAIT_L(0); PG8_MMA(1, 0, At, B0); PG8_BAR; PG8_SCHED;
            PG8_STAGE(PG8_SB(0, 1), b2 + hstep, voffB);
            PG8_WAIT_V(6); PG8_BAR; PG8_MMA(1, 1, At, B1); PG8_BAR;
            PG8_LDB(B0, 1, 0); PG8_SCHED; PG8_LDA(At, 1, 0); PG8_STAGE(PG8_SA(0, 1), a2 + hstep, voffA);
            PG8_WAIT_L(8); PG8_BAR; PG8_WAIT_L(0); PG8_MMA(0, 0, At, B0); PG8_BAR; PG8_SCHED;
            PG8_LDB(B1, 1, 1); PG8_STAGE(PG8_SB(1, 0), b3, voffB);
            PG8_BAR; PG8_WAIT_L(0); PG8_MMA(0, 1, At, B1); PG8_BAR;
            PG8_LDA(At, 1, 1); PG8_STAGE(PG8_SA(1, 0), a3, voffA);
            PG8_BAR; PG8_WAIT_L(0); PG8_MMA(1, 0, At, B0); PG8_BAR; PG8_SCHED;
            PG8_STAGE(PG8_SB(1, 1), b3 + hstep, voffB);
            PG8_WAIT_V(6); PG8_BAR; PG8_MMA(1, 1, At, B1); PG8_BAR;
            }
        }
        if constexpr (ALIGN_EPI) { if (wr == 0) PG8_BAR; }
        if constexpr (!Epi::AFTER_DRAIN) { E(acc, cur, wr, wc, fr, fq); S.done(cur); }
        if (!has_next) break;
#pragma unroll
        for (int a = 0; a < 2; ++a)
#pragma unroll
            for (int b = 0; b < 2; ++b)
#pragma unroll
                for (int m = 0; m < 4; ++m)
#pragma unroll
                    for (int n = 0; n < 2; ++n) acc[a][b][m][n] = (f32x4){0.f, 0.f, 0.f, 0.f};
        cur = nxt; cA = nA; cB = nB; ++ui;
        if constexpr (ALIGN_EPI) { if (wr == 1) PG8_BAR; }
    }
    PG8_WAIT_V(0);
    if constexpr (!ALIGN_EPI) { if (wr == 0) PG8_BAR; }
    PG8_BAR;
    if constexpr (Epi::AFTER_DRAIN) { E.fused(acc, cur, wr, wc, fr, fq, lds, wid, lane); S.done(cur); }
#undef PG8_SA
#undef PG8_SB
#undef PG8_STAGE
#undef PG8_LDA
#undef PG8_LDB
#undef PG8_MMA
#undef PG8_WAIT_V
#undef PG8_WAIT_L
#undef PG8_BAR
#undef PG8_SCHED
}
}

#ifndef PG8_SP2
#define PG8_SP2 true
#endif
#ifndef PG8_ALIGN
#define PG8_ALIGN true
#endif
constexpr int NWAVES = 8;
#ifndef MK_N_LAUNCHES
#define MK_N_LAUNCHES 1
#endif
constexpr int N_LAUNCHES = MK_N_LAUNCHES;
constexpr int PER_PHASE = 7;

constexpr int BATCH = 16, T = 2048, D = 2048, M = BATCH * T;
constexpr int NIN = 8528, NINP = 8704;
constexpr int C_QA = 0, C_KA = 1024, C_VA = 2048, C_ZA = 3072, C_QB = 4096, C_CKV = 6144, C_ZB = 6400, C_IQ = 7424, C_IK = 8448, C_IW = 8512;
constexpr int DO = 2048;
constexpr int TOPK = 256;
constexpr float EPS = 1e-6f;

constexpr size_t MiB = 1u << 20;
constexpr size_t WS_CTL = 0, CTL_ZERO_BYTES = 1 * MiB;
constexpr size_t WS_WIN = 2 * MiB;
constexpr size_t WS_WOUT = 36 * MiB;
constexpr size_t WS_WUV = 44 * MiB;
constexpr size_t WS_CKV = 48 * MiB;
constexpr size_t WS_IK = 64 * MiB;
constexpr size_t WS_BM = 68 * MiB;
constexpr size_t WS_H = 76 * MiB;
constexpr size_t WS_P = 204 * MiB;
constexpr size_t WS_END = 748 * MiB;
constexpr int CW_TMO = 0, CW_CODE = 1;
constexpr int CW_BAR = 4096;

constexpr int RING_OFF = 0, RING_BYTES = 131072;
constexpr int LDSCTL_OFF = RING_BYTES, MISC_OFF = LDSCTL_OFF + 320;
constexpr int UP_OFF = MISC_OFF + 128;
constexpr int LDS_BYTES = 147456;
static_assert(UP_OFF + 8 * 1024 <= LDS_BYTES, "LDS map");
#define GAS __attribute__((address_space(1)))
#define LAS __attribute__((address_space(3)))
typedef unsigned short bf16;
typedef unsigned v4u __attribute__((ext_vector_type(4)));
typedef float f32x4 __attribute__((ext_vector_type(4)));
typedef short bf16x8 __attribute__((ext_vector_type(8)));
typedef GAS unsigned gu32;
typedef GAS unsigned long long gu64;
#define RLX_AGENT __ATOMIC_RELAXED, __HIP_MEMORY_SCOPE_AGENT
#define LDS_WAIT() asm volatile("s_waitcnt lgkmcnt(0)" ::: "memory")
#define VM_WAIT() asm volatile("s_waitcnt vmcnt(0)" ::: "memory")
__device__ __forceinline__ unsigned long long rt() { return __builtin_amdgcn_s_memrealtime(); }
__device__ __forceinline__ unsigned f2bf(float f) { unsigned u = __builtin_bit_cast(unsigned, f); return (u + 0x7fffu + ((u >> 16) & 1u)) >> 16; }
__device__ __forceinline__ unsigned pk2(float lo, float hi) { return f2bf(lo) | (f2bf(hi) << 16); }

#define XB_TMO      128
#define XB_XCNT(j)  (256  + 64 * (j))
#define XB_XSUB(j)  (1280 + 64 * (j))
#define XB_XGEN(j)  (2304 + 64 * (j))
#define XB_TOP      3328
#define XB_TOPGEN   3392
#define XCD_BAR_WORDS 3456
#define XB_SPIN_CAP (1u << 24)

__device__ __forceinline__ unsigned xb_ld(unsigned* p)              { return __hip_atomic_load(p, __ATOMIC_RELAXED, __HIP_MEMORY_SCOPE_AGENT); }
__device__ __forceinline__ unsigned xb_add(unsigned* p, unsigned v) { return __hip_atomic_fetch_add(p, v, __ATOMIC_RELAXED, __HIP_MEMORY_SCOPE_AGENT); }
__device__ __forceinline__ unsigned xb_xcc_id() { return (unsigned)__builtin_amdgcn_s_getreg((3 << 11) | 20) & 0xFu; }
#define XB_SPIN(cond, bar) do { unsigned _sp = 0; while (cond) { __builtin_amdgcn_s_sleep(1); \
    if ((++_sp & 255u) == 0u) { if (xb_ld(&(bar)[XB_TMO])) break; if (_sp > XB_SPIN_CAP) { atomicAdd(&(bar)[XB_TMO], 1u); break; } } } } while (0)

__device__ __forceinline__ int mk_lane() { return (int)__builtin_amdgcn_mbcnt_hi(~0u, __builtin_amdgcn_mbcnt_lo(~0u, 0u)); }
struct XcdBarrier {
    int wv;
    unsigned* bar; unsigned x;
    volatile LAS unsigned* st;
};

__device__ __forceinline__ XcdBarrier xcd_barrier_post(unsigned* bar, volatile LAS unsigned* st, int wv) {
    XcdBarrier b; b.wv = wv; b.bar = bar; b.x = xb_xcc_id(); b.st = st;
    if (wv == 0 && mk_lane() == 0) (void)xb_add(&bar[XB_XCNT(b.x)], 1u);
    return b;
}
__device__ __forceinline__ void xcd_barrier_complete(unsigned* bar, unsigned x, unsigned& nloc, unsigned& nx) {
    const unsigned G = gridDim.x * gridDim.y * gridDim.z;
    unsigned sum, cnt, mine, sp = 0u;
    for (;;) {
        sum = 0u; cnt = 0u; mine = 0u;
#pragma unroll
        for (unsigned j = 0; j < 16; ++j) { const unsigned c = xb_ld(&bar[XB_XCNT(j)]); sum += c; cnt += (c > 0u) ? 1u : 0u; mine = (j == x) ? c : mine; }
        if (sum == G) break;
        __builtin_amdgcn_s_sleep(1);
        if ((++sp & 255u) == 0u) { if (xb_ld(&bar[XB_TMO])) break; if (sp > XB_SPIN_CAP) { atomicAdd(&bar[XB_TMO], 1u); break; } }
    }
    nloc = mine > 0u ? mine : 1u; nx = cnt > 0u ? cnt : 1u;
}

__device__ __forceinline__ void xcd_barrier(const XcdBarrier& b) {
    asm volatile("s_waitcnt vmcnt(0)" ::: "memory");
    __syncthreads();
    if (b.wv == 0 && mk_lane() == 0) {
        unsigned* bar = b.bar;
        __builtin_amdgcn_s_waitcnt(0);
        unsigned nloc = b.st[0], nx = b.st[1];
        if (nloc == 0u) { xcd_barrier_complete(bar, b.x, nloc, nx); b.st[0] = nloc; b.st[1] = nx; }
        const unsigned old = xb_add(&bar[XB_XSUB(b.x)], 1u);
        const unsigned gen = old / nloc;
        if (old + 1u == (gen + 1u) * nloc) {
            __builtin_amdgcn_fence(__ATOMIC_RELEASE, "agent");
            asm volatile("s_waitcnt vmcnt(0)" ::: "memory");
            const unsigned og = xb_add(&bar[XB_TOP], 1u);
            const unsigned tg = og / nx;
            if (og + 1u == (tg + 1u) * nx) xb_add(&bar[XB_TOPGEN], 1u);
            else XB_SPIN(xb_ld(&bar[XB_TOPGEN]) == tg, bar);
            __builtin_amdgcn_fence(__ATOMIC_ACQUIRE, "agent");
            xb_add(&bar[XB_XGEN(b.x)], 1u);
            asm volatile("s_waitcnt vmcnt(0)" ::: "memory");
        } else {
            XB_SPIN(xb_ld(&bar[XB_XGEN(b.x)]) == gen, bar);
            __builtin_amdgcn_fence(__ATOMIC_ACQUIRE, "agent");
            asm volatile("s_waitcnt vmcnt(0)" ::: "memory");
        }
    }
    __syncthreads();
}
#ifndef REPEAT_PHASE
#define REPEAT_PHASE -1
#endif
struct Frame {
    LAS unsigned char* lds;
    volatile LAS unsigned* MISC;
    gu32* ctl;
    int wave;
    int vcu, G;
    const float *x, *g_pre, *w_in, *lq1, *lk1, *lq2, *lk2, *subln_g, *kvn_g, *ikn_g, *w_uv, *rel_bias, *w_out, *g_post;
    float* out;
    bf16 *WinT, *WoutT, *WuvT, *CKVn, *IKn, *H, *O, *P, *Y;
    unsigned* BM;
};

__device__ __forceinline__ float wave_sum(float v) {
#pragma unroll
    for (int o = 1; o < 64; o <<= 1) v += __shfl_xor(v, o);
    return v;
}
__device__ __forceinline__ float wave_max(float v) {
#pragma unroll
    for (int o = 1; o < 64; o <<= 1) v = fmaxf(v, __shfl_xor(v, o));
    return v;
}
__device__ __forceinline__ float bf2f(unsigned short b) { return __uint_as_float((unsigned)b << 16); }
__device__ __forceinline__ float bflo(unsigned w) { return __uint_as_float(w << 16); }
__device__ __forceinline__ float bfhi(unsigned w) { return __uint_as_float(w & 0xffff0000u); }
__device__ __forceinline__ float silu(float z) { return z * __builtin_amdgcn_rcpf(1.f + __builtin_amdgcn_exp2f(-1.4426950408889634f * z)); }
__device__ __forceinline__ int t5_bucket(int n) {
    if (n < 16) return n;
    return 16 + (n >= 19) + (n >= 21) + (n >= 24) + (n >= 27) + (n >= 31) + (n >= 35) + (n >= 40) + (n >= 46) + (n >= 52) + (n >= 59) + (n >= 67) + (n >= 77) + (n >= 87) + (n >= 99) + (n >= 113);
}

__device__ __forceinline__ void p0_transpose_item(const float* W, int K, int N, int nblk, bf16* WT, LAS float* scr, int item, int lane) {
    const int kb = item / nblk, nb = item % nblk, k0 = 64 * kb, n0 = 32 * nb;
    const int rr = lane >> 3, c4 = lane & 7; const bool ok = n0 + 4 * c4 < N;
    f32x4 v[8];
#pragma unroll
    for (int i = 0; i < 8; ++i) v[i] = ok ? *(const GAS f32x4*)(W + (size_t)(k0 + 8 * i + rr) * N + n0 + 4 * c4) : (f32x4){0.f, 0.f, 0.f, 0.f};
#pragma unroll
    for (int i = 0; i < 8; ++i) { LAS float* d = scr + (8 * i + rr) * 33 + 4 * c4; d[0] = v[i].x; d[1] = v[i].y; d[2] = v[i].z; d[3] = v[i].w; }
    LDS_WAIT(); asm volatile("" ::: "memory");
    const int c = lane & 7;
#pragma unroll
    for (int j = 0; j < 4; ++j) { const int n = (lane >> 3) + 8 * j; const LAS float* s = scr + (8 * c) * 33 + n;
        v4u o; o.x = pk2(s[0 * 33], s[1 * 33]); o.y = pk2(s[2 * 33], s[3 * 33]); o.z = pk2(s[4 * 33], s[5 * 33]); o.w = pk2(s[6 * 33], s[7 * 33]);
        *(GAS v4u*)(WT + (size_t)(n0 + n) * K + k0 + 8 * c) = o; }
    LDS_WAIT(); asm volatile("" ::: "memory");
}
__device__ __forceinline__ void rms_rows4_to_bf16(const float* xrow, const float* g, bf16* orow, int lane) {
    f32x4 v[4][8]; float s[4];
#pragma unroll
    for (int r = 0; r < 4; ++r) { const GAS f32x4* xr = (const GAS f32x4*)(xrow + (size_t)r * D) + lane;
#pragma unroll
        for (int j = 0; j < 8; ++j) v[r][j] = xr[64 * j]; }
#pragma unroll
    for (int r = 0; r < 4; ++r) { float a = 0.f;
#pragma unroll
        for (int j = 0; j < 8; ++j) a += (v[r][j].x * v[r][j].x + v[r][j].y * v[r][j].y) + (v[r][j].z * v[r][j].z + v[r][j].w * v[r][j].w);
        s[r] = a; }
#pragma unroll
    for (int o = 1; o < 64; o <<= 1) {
#pragma unroll
        for (int r = 0; r < 4; ++r) s[r] += __shfl_xor(s[r], o); }
    const GAS f32x4* gr = (const GAS f32x4*)g + lane;
#pragma unroll
    for (int r = 0; r < 4; ++r) { const float rstd = rsqrtf(s[r] * (1.f / D) + EPS); GAS unsigned long long* o8 = (GAS unsigned long long*)(orow + (size_t)r * D) + lane;
#pragma unroll
        for (int j = 0; j < 8; ++j) { const f32x4 gg = gr[64 * j];
            o8[64 * j] = (unsigned long long)pk2(v[r][j].x * rstd * gg.x, v[r][j].y * rstd * gg.y) | ((unsigned long long)pk2(v[r][j].z * rstd * gg.z, v[r][j].w * rstd * gg.w) << 32); } }
}
__device__ __forceinline__ void p0_prologue(Frame& F) {
    LAS float* scr = (LAS float*)(F.lds + RING_OFF + F.wave * 16384);
    const int gw = F.vcu * NWAVES + F.wave, NGW = F.G * NWAVES;
    constexpr int I_IN = (D / 64) * (NINP / 32), I_OUT = (DO / 64) * (D / 32);
    for (int it = gw; it < I_IN + I_OUT; it += NGW) {
        if (it < I_IN) p0_transpose_item(F.w_in, D, NIN, NINP / 32, F.WinT, scr, it, mk_lane());
        else p0_transpose_item(F.w_out, DO, D, D / 32, F.WoutT, scr, it - I_IN, mk_lane());
    }
    for (int e = (F.vcu * NWAVES + F.wave) * 64 + mk_lane(); e < 8 * 128 * 256; e += F.G * NWAVES * 64) { const int j = e & 7, ln = (e >> 3) & 63, i = (e >> 9) & 15, mt = (e >> 13) & 3, hh = e >> 15;
        const int d = 32 * mt + (ln & 31), c = 32 * (i >> 1) + 16 * (i & 1) + 8 * (j >> 2) + 4 * (ln >> 5) + (j & 3);
        F.WuvT[e] = (bf16)f2bf(F.w_uv[((size_t)hh * 256 + c) * 128 + d]); }
    for (int m = 4 * gw; m < M; m += 4 * NGW) rms_rows4_to_bf16(F.x + (size_t)m * D, F.g_pre, F.H + (size_t)m * D, mk_lane());
}

__device__ __forceinline__ void p2_norms(Frame& F) {
    const int gw = F.vcu * NWAVES + F.wave, NGW = F.G * NWAVES, lane = mk_lane();
    const f32x4 g = *((const GAS f32x4*)F.kvn_g + lane); const float gk = F.ikn_g[lane];
    for (int m0 = 4 * gw; m0 < M; m0 += 4 * NGW) {
        unsigned long long cv[4]; unsigned short kv16[4];
#pragma unroll
        for (int r = 0; r < 4; ++r) { const bf16* pr = F.P + (size_t)(m0 + r) * NINP; cv[r] = *(const GAS unsigned long long*)(pr + C_CKV + 4 * lane); kv16[r] = pr[C_IK + lane]; }
        float sc[4], sk[4], c0[4], c1[4], c2[4], c3[4], kv[4];
#pragma unroll
        for (int r = 0; r < 4; ++r) { c0[r] = bflo((unsigned)cv[r]); c1[r] = bfhi((unsigned)cv[r]); c2[r] = bflo((unsigned)(cv[r] >> 32)); c3[r] = bfhi((unsigned)(cv[r] >> 32)); kv[r] = bf2f(kv16[r]);
            sc[r] = (c0[r] * c0[r] + c1[r] * c1[r]) + (c2[r] * c2[r] + c3[r] * c3[r]); sk[r] = kv[r] * kv[r]; }
#pragma unroll
        for (int o = 1; o < 64; o <<= 1) {
#pragma unroll
            for (int r = 0; r < 4; ++r) { sc[r] += __shfl_xor(sc[r], o); sk[r] += __shfl_xor(sk[r], o); } }
#pragma unroll
        for (int r = 0; r < 4; ++r) { const float rc = rsqrtf(sc[r] * (1.f / 256.f) + EPS), rk = rsqrtf(sk[r] * (1.f / 64.f) + EPS); const size_t m = (size_t)(m0 + r);
            *((GAS unsigned long long*)(F.CKVn + m * 256) + lane) = (unsigned long long)pk2(c0[r] * rc * g.x, c1[r] * rc * g.y) | ((unsigned long long)pk2(c2[r] * rc * g.z, c3[r] * rc * g.w) << 32);
            F.IKn[m * 64 + lane] = (bf16)f2bf(kv[r] * rk * gk); }
    }
}

__device__ __forceinline__ void naive_diff_attn(Frame& F, int b, int h, int t, float lam, LAS float* L1, LAS float* L2, LAS float* qs) {
    const int lane = mk_lane(); const size_t row = (size_t)b * T + t;
    const bf16* Prow = F.P + row * NINP;
    qs[lane] = bf2f(Prow[C_QA + h * 64 + lane]); qs[64 + lane] = bf2f(Prow[C_QA + 512 + h * 64 + lane]);
    float m1 = -INFINITY, m2 = -INFINITY;
    for (int s0 = 0; s0 <= t; s0 += 64) { const int s = s0 + lane;
        if (s <= t) {
            const bf16* kr = F.P + ((size_t)b * T + s) * NINP + C_KA + h * 64;
            float a1 = 0.f, a2 = 0.f;
#pragma unroll
            for (int c = 0; c < 8; ++c) { const v4u k1 = *(const GAS v4u*)(kr + 8 * c), k2 = *(const GAS v4u*)(kr + 512 + 8 * c);
                const LAS float* q1 = qs + 8 * c; const LAS float* q2 = qs + 64 + 8 * c;
                a1 += q1[0] * bflo(k1.x) + q1[1] * bfhi(k1.x) + q1[2] * bflo(k1.y) + q1[3] * bfhi(k1.y) + q1[4] * bflo(k1.z) + q1[5] * bfhi(k1.z) + q1[6] * bflo(k1.w) + q1[7] * bfhi(k1.w);
                a2 += q2[0] * bflo(k2.x) + q2[1] * bfhi(k2.x) + q2[2] * bflo(k2.y) + q2[3] * bfhi(k2.y) + q2[4] * bflo(k2.z) + q2[5] * bfhi(k2.z) + q2[6] * bflo(k2.w) + q2[7] * bfhi(k2.w); }
            const float bias = F.rel_bias[t5_bucket(t - s) * 16 + h];
            a1 = a1 * 0.125f + bias; a2 = a2 * 0.125f + bias;
            L1[s] = a1; L2[s] = a2; m1 = fmaxf(m1, a1); m2 = fmaxf(m2, a2);
        } }
    m1 = wave_max(m1); m2 = wave_max(m2);
    float s1 = 0.f, s2 = 0.f;
    for (int s = lane; s <= t; s += 64) { const float e1 = __expf(L1[s] - m1), e2 = __expf(L2[s] - m2); L1[s] = e1; L2[s] = e2; s1 += e1; s2 += e2; }
    s1 = wave_sum(s1); s2 = wave_sum(s2);
    const float i1 = 1.f / s1, i2 = lam / s2;
    for (int s = lane; s <= t; s += 64) L1[s] = L1[s] * i1 - L2[s] * i2;
    float o0 = 0.f, o1 = 0.f; const bf16* vb = F.P + (size_t)b * T * NINP + C_VA + h * 128 + 2 * lane;
    for (int s = 0; s <= t; ++s) { const float a = L1[s]; const unsigned vv = *(const GAS unsigned*)(vb + (size_t)s * NINP); o0 += a * bflo(vv); o1 += a * bfhi(vv); }
    const float ss = wave_sum(o0 * o0 + o1 * o1); const float rs = rsqrtf(ss * (1.f / 128.f) + EPS) * 0.8f;
    const unsigned zz = *(const GAS unsigned*)(Prow + C_ZA + h * 128 + 2 * lane);
    const float r0 = o0 * rs * F.subln_g[2 * lane] * silu(bflo(zz)), r1 = o1 * rs * F.subln_g[2 * lane + 1] * silu(bfhi(zz));
    *(GAS unsigned*)(F.O + row * DO + h * 128 + 2 * lane) = pk2(r0, r1);
}

__device__ __forceinline__ unsigned skey(float f) { const unsigned u = __float_as_uint(f); return (u & 0x80000000u) ? ~u : (u | 0x80000000u); }
__device__ __forceinline__ void naive_dsa(Frame& F, int b, int t, LAS unsigned char* wl) {
    LAS float* S = (LAS float*)wl; LAS float* IQ = (LAS float*)(wl + 8192); LAS float* QH = (LAS float*)(wl + 12288); LAS float* PP = (LAS float*)(wl + 13312);
    LAS int* SEL = (LAS int*)(wl + 14336); LAS float* OL = (LAS float*)(wl + 15360);
    const int lane = mk_lane(); const size_t row = (size_t)b * T + t; const bf16* Prow = F.P + row * NINP;
    for (int i = lane; i < 1024; i += 64) IQ[i] = bf2f(Prow[C_IQ + i]);
    float w[16];
#pragma unroll
    for (int hh = 0; hh < 16; ++hh) w[hh] = bf2f(Prow[C_IW + hh]) * 0.25f;
    for (int s0 = 0; s0 <= t; s0 += 64) { const int s = s0 + lane;
        if (s <= t) {
            const bf16* kr = F.IKn + ((size_t)b * T + s) * 64;
            float acc[16];
#pragma unroll
            for (int hh = 0; hh < 16; ++hh) acc[hh] = 0.f;
#pragma unroll
            for (int c = 0; c < 8; ++c) { const v4u kk = *(const GAS v4u*)(kr + 8 * c);
                const float k0 = bflo(kk.x), k1 = bfhi(kk.x), k2 = bflo(kk.y), k3 = bfhi(kk.y), k4 = bflo(kk.z), k5 = bfhi(kk.z), k6 = bflo(kk.w), k7 = bfhi(kk.w);
#pragma unroll
                for (int hh = 0; hh < 16; ++hh) { const LAS float* q = IQ + hh * 64 + 8 * c;
                    acc[hh] += q[0] * k0 + q[1] * k1 + q[2] * k2 + q[3] * k3 + q[4] * k4 + q[5] * k5 + q[6] * k6 + q[7] * k7; } }
            float sc = 0.f;
#pragma unroll
            for (int hh = 0; hh < 16; ++hh) sc += w[hh] * fmaxf(acc[hh] * 0.125f, 0.f);
            S[s] = sc;
        } }
    const int n = t + 1; int nsel;
    if (n <= TOPK) { for (int i = lane; i < n; i += 64) SEL[i] = i; nsel = n; }
    else {
        unsigned thr = 0u;
        for (int bit = 31; bit >= 0; --bit) { const unsigned cand = thr | (1u << bit); int cnt = 0;
            for (int s0 = 0; s0 < n; s0 += 64) { const int s = s0 + lane; const bool ge = (s < n) && (skey(S[s]) >= cand); cnt += __popcll(__ballot(ge)); }
            if (cnt >= TOPK) thr = cand; }
        int cgt = 0;
        for (int s0 = 0; s0 < n; s0 += 64) { const int s = s0 + lane; const bool gt = (s < n) && (skey(S[s]) > thr); cgt += __popcll(__ballot(gt)); }
        const int need = TOPK - cgt; int pos = 0, eqseen = 0; const unsigned long long lt = (1ull << lane) - 1ull;
        for (int s0 = 0; s0 < n; s0 += 64) { const int s = s0 + lane; const bool valid = s < n; const unsigned k = valid ? skey(S[s]) : 0u;
            const bool gt = valid && k > thr, eq = valid && k == thr; const unsigned long long meq = __ballot(eq);
            const bool take = gt || (eq && (eqseen + __popcll(meq & lt)) < need); const unsigned long long mt = __ballot(take);
            if (take) SEL[pos + __popcll(mt & lt)] = s;
            pos += __popcll(mt); eqseen += __popcll(meq); }
        nsel = pos;
    }
    for (int h = 0; h < 8; ++h) {
#pragma unroll
        for (int i = 0; i < 4; ++i) QH[lane + 64 * i] = bf2f(Prow[C_QB + h * 256 + lane + 64 * i]);
        float lg[4]; float mx = -INFINITY;
#pragma unroll
        for (int i = 0; i < 4; ++i) { const int k = lane + 64 * i; lg[i] = -INFINITY;
            if (k < nsel) { const int s = SEL[k]; const bf16* cr = F.CKVn + ((size_t)b * T + s) * 256; float a = 0.f;
                for (int c = 0; c < 32; ++c) { const v4u kk = *(const GAS v4u*)(cr + 8 * c); const LAS float* q = QH + 8 * c;
                    a += q[0] * bflo(kk.x) + q[1] * bfhi(kk.x) + q[2] * bflo(kk.y) + q[3] * bfhi(kk.y) + q[4] * bflo(kk.z) + q[5] * bfhi(kk.z) + q[6] * bflo(kk.w) + q[7] * bfhi(kk.w); }
                lg[i] = a * 0.0625f + F.rel_bias[t5_bucket(t - s) * 16 + 8 + h]; mx = fmaxf(mx, lg[i]); } }
        mx = wave_max(mx); float sm = 0.f;
#pragma unroll
        for (int i = 0; i < 4; ++i) { lg[i] = (lane + 64 * i < nsel) ? __expf(lg[i] - mx) : 0.f; sm += lg[i]; }
        sm = wave_sum(sm); const float inv = 1.f / sm;
#pragma unroll
        for (int i = 0; i < 4; ++i) PP[lane + 64 * i] = lg[i] * inv;
        float o0 = 0.f, o1 = 0.f, o2 = 0.f, o3 = 0.f;
        for (int k = 0; k < nsel; ++k) { const int s = SEL[k]; const float p = PP[k];
            const unsigned long long cv = *(const GAS unsigned long long*)(F.CKVn + ((size_t)b * T + s) * 256 + 4 * lane);
            o0 += p * bflo((unsigned)cv); o1 += p * bfhi((unsigned)cv); o2 += p * bflo((unsigned)(cv >> 32)); o3 += p * bfhi((unsigned)(cv >> 32)); }
        OL[4 * lane] = o0; OL[4 * lane + 1] = o1; OL[4 * lane + 2] = o2; OL[4 * lane + 3] = o3;
        float a0 = 0.f, a1 = 0.f; const float* wu = F.w_uv + (size_t)h * 256 * 128 + 2 * lane;
        for (int c = 0; c < 256; ++c) { const float o = OL[c]; const float2 ww = *(const float2*)(wu + c * 128); a0 += o * ww.x; a1 += o * ww.y; }
        const unsigned zz = *(const GAS unsigned*)(Prow + C_ZB + h * 128 + 2 * lane);
        *(GAS unsigned*)(F.O + row * DO + 1024 + h * 128 + 2 * lane) = pk2(a0 * silu(bflo(zz)), a1 * silu(bfhi(zz)));
    }
}


typedef float f32x16 __attribute__((ext_vector_type(16)));
typedef short v4i16_t __attribute__((ext_vector_type(4)));
typedef float f32x2_t __attribute__((ext_vector_type(2))); typedef __bf16 bf16x2_t __attribute__((ext_vector_type(2)));
constexpr float LOG2E = 1.4426950408889634f;
#define MFMA32(a, b, c) __builtin_amdgcn_mfma_f32_32x32x16_bf16((a), (b), (c), 0, 0, 0)
__device__ __forceinline__ void glds16(const void* gsrc, unsigned lds_dst) { unsigned keep;
    asm volatile("s_mov_b32 %0, m0\n\ts_mov_b32 m0, %2\n\ts_nop 0\n\tglobal_load_lds_dwordx4 %1, off\n\ts_mov_b32 m0, %0" : "=&s"(keep) : "v"(gsrc), "s"(lds_dst) : "memory"); }
#define GLDS16(gp, lp) glds16((const void*)(gp), (unsigned)__builtin_amdgcn_readfirstlane((int)(unsigned)(size_t)(lp)))
#define DMA_WAIT_BAR() do { asm volatile("s_waitcnt vmcnt(0)" ::: "memory"); __syncthreads(); } while (0)
__device__ __forceinline__ unsigned cvtpk(float lo, float hi) { f32x2_t v = {lo, hi}; bf16x2_t b = __builtin_convertvector(v, bf16x2_t); return __builtin_bit_cast(unsigned, b); }
__device__ __forceinline__ float xhalf_max(float v) { auto rr = __builtin_amdgcn_permlane32_swap(__float_as_uint(v), __float_as_uint(v), false, false); return fmaxf(__uint_as_float(rr[0]), __uint_as_float(rr[1])); }
__device__ __forceinline__ float xhalf_sum(float v) { auto rr = __builtin_amdgcn_permlane32_swap(__float_as_uint(v), __float_as_uint(v), false, false); return __uint_as_float(rr[0]) + __uint_as_float(rr[1]); }
__device__ __forceinline__ bf16x8 pack8(const f32x16& x, int s) {
    v4u p; p.x = cvtpk(x[8 * s], x[8 * s + 1]); p.y = cvtpk(x[8 * s + 2], x[8 * s + 3]); p.z = cvtpk(x[8 * s + 4], x[8 * s + 5]); p.w = cvtpk(x[8 * s + 6], x[8 * s + 7]);
    return __builtin_bit_cast(bf16x8, p);
}
__device__ __forceinline__ bf16x8 tr_pair(LAS unsigned char* a0, LAS unsigned char* a1) {
    const v4i16_t lo = __builtin_amdgcn_ds_read_tr16_b64_v4i16((LAS v4i16_t*)a0), hi = __builtin_amdgcn_ds_read_tr16_b64_v4i16((LAS v4i16_t*)a1);
    return (bf16x8){lo[0], lo[1], lo[2], lo[3], hi[0], hi[1], hi[2], hi[3]};
}
template <int NB>
__device__ __forceinline__ void softmax_step(f32x16& x, float& mhat, float& lsum, f32x16 (&o)[NB]) {
    float mt = fmaxf(fmaxf(x[0], x[1]), fmaxf(x[2], x[3]));
#pragma unroll
    for (int i = 4; i < 16; i += 4) mt = fmaxf(mt, fmaxf(fmaxf(x[i], x[i + 1]), fmaxf(x[i + 2], x[i + 3])));
    mt = xhalf_max(mt);
    if (__any(mt > mhat + 8.f)) {
        const float mnew = fmaxf(mhat, mt), f = __builtin_amdgcn_exp2f(mhat - mnew);
        lsum *= f;
#pragma unroll
        for (int d = 0; d < NB; ++d) o[d] *= f;
        mhat = mnew;
    }
    x -= mhat;
#pragma unroll
    for (int i = 0; i < 16; ++i) x[i] = __builtin_amdgcn_exp2f(x[i]);
    const float a0 = (x[0] + x[1]) + (x[2] + x[3]), a1 = (x[4] + x[5]) + (x[6] + x[7]), a2 = (x[8] + x[9]) + (x[10] + x[11]), a3 = (x[12] + x[13]) + (x[14] + x[15]);
    lsum += (a0 + a1) + (a2 + a3);
}
template <int NB>
__device__ __forceinline__ void softmax_step_raw(f32x16& x, const float c, float& mhat, float& lsum, f32x16 (&o)[NB]) {
    float mt = fmaxf(fmaxf(x[0], x[1]), fmaxf(x[2], x[3]));
#pragma unroll
    for (int i = 4; i < 16; i += 4) mt = fmaxf(mt, fmaxf(fmaxf(x[i], x[i + 1]), fmaxf(x[i + 2], x[i + 3])));
    mt = xhalf_max(mt) * c;
    if (__any(mt > mhat + 8.f)) {
        const float mnew = fmaxf(mhat, mt), f = __builtin_amdgcn_exp2f(mhat - mnew);
        lsum *= f;
#pragma unroll
        for (int d = 0; d < NB; ++d) o[d] *= f;
        mhat = mnew;
    }
    x = x * c - mhat;
#pragma unroll
    for (int i = 0; i < 16; ++i) x[i] = __builtin_amdgcn_exp2f(x[i]);
    const float a0 = (x[0] + x[1]) + (x[2] + x[3]), a1 = (x[4] + x[5]) + (x[6] + x[7]), a2 = (x[8] + x[9]) + (x[10] + x[11]), a3 = (x[12] + x[13]) + (x[14] + x[15]);
    lsum += (a0 + a1) + (a2 + a3);
}
template <int NB>
__device__ __forceinline__ void softmax_step2(f32x16& x, f32x16& y, float& mhat, float& lsum, f32x16 (&o)[NB]) {
    float mt = fmaxf(fmaxf(x[0], x[1]), fmaxf(x[2], x[3])), mu = fmaxf(fmaxf(y[0], y[1]), fmaxf(y[2], y[3]));
#pragma unroll
    for (int i = 4; i < 16; i += 4) { mt = fmaxf(mt, fmaxf(fmaxf(x[i], x[i + 1]), fmaxf(x[i + 2], x[i + 3]))); mu = fmaxf(mu, fmaxf(fmaxf(y[i], y[i + 1]), fmaxf(y[i + 2], y[i + 3]))); }
    mt = xhalf_max(fmaxf(mt, mu));
    if (__any(mt > mhat + 8.f)) {
        const float mnew = fmaxf(mhat, mt), f = __builtin_amdgcn_exp2f(mhat - mnew);
        lsum *= f;
#pragma unroll
        for (int d = 0; d < NB; ++d) o[d] *= f;
        mhat = mnew;
    }
    float acc = 0.f, acd = 0.f;
#pragma unroll
    for (int i = 0; i < 16; ++i) { x[i] = __builtin_amdgcn_exp2f(x[i] - mhat); acc += x[i]; y[i] = __builtin_amdgcn_exp2f(y[i] - mhat); acd += y[i]; }
    lsum += acc + acd;
}

constexpr int AT_STAGE = 32768, AT_Q2 = 65536, AT_LUT = UP_OFF - RING_OFF;
constexpr int A_K1 = 0, A_K2 = 8192, A_V = 16384;
__device__ __forceinline__ void a_load_q(Frame& F, int b, int h, int qb, bf16x8 (&qn)[8]) {
    int lane = mk_lane(), w = F.wave; asm volatile("" : "+v"(lane), "+s"(w));
    const bf16* qrow = F.P + ((size_t)b * T + qb * 256 + 32 * w + (lane & 31)) * NINP + C_QA + h * 64 + 8 * (lane >> 5);
#pragma unroll
    for (int ks = 0; ks < 4; ++ks) { qn[ks] = *(const GAS bf16x8*)(qrow + 512 + 16 * ks); qn[4 + ks] = *(const GAS bf16x8*)(qrow + 16 * ks); }
}
__device__ __forceinline__ void a_unit(Frame& F, int b, int h, int qb, float lam, bf16x8 (&qn)[8], int nb, int nh, int nqb) {
    LAS unsigned char* L = F.lds + RING_OFF;
    int lane = mk_lane(), w = F.wave; asm volatile("" : "+v"(lane), "+s"(w));
    const int r32 = lane & 31, hi = lane >> 5;
    const int q0 = qb * 256, tq0 = q0 + 32 * w;
    const size_t rowb = (size_t)b * T;
    LAS float* LUT = (LAS float*)(L + AT_LUT);
    __syncthreads();
    if ((F.wave * 64 + mk_lane()) < 256) { const int dist = 191 - (F.wave * 64 + mk_lane()); LUT[(F.wave * 64 + mk_lane())] = (dist >= 0 && dist < 128) ? (F.rel_bias[t5_bucket(dist) * 16 + h] - F.rel_bias[31 * 16 + h]) * 8.f : 0.f; }
    LAS unsigned char* q2p = L + AT_Q2 + w * 8192 + lane * 16;
#pragma unroll
    for (int ks = 0; ks < 4; ++ks) { *(LAS bf16x8*)(q2p + 4096 + ks * 1024) = qn[4 + ks]; *(LAS bf16x8*)(q2p + ks * 1024) = qn[ks]; }
    f32x16 o1[4], o2[4];
#pragma unroll
    for (int d = 0; d < 4; ++d) { o1[d] = (f32x16){}; o2[d] = (f32x16){}; }
    float m1 = -1e30f, m2 = -1e30f, l1 = 0.f, l2 = 0.f;
    const int NT = (q0 + 256) / 64;
    const bf16* ksrc = F.P + (rowb + 32 * (w >> 2) + r32) * NINP + C_KA + h * 64 + 8 * (2 * (w & 3) + hi);
    const bf16* vsrc;
    { const int m = lane & 31, vrow = 32 * (w >> 2) + 16 * ((w >> 1) & 1) + 8 * (w & 1) + 4 * (m >> 4) + ((m >> 1) & 3), vd0 = 32 * (lane >> 5) + 16 * ((m >> 3) & 1) + 8 * (m & 1);
      vsrc = F.P + (rowb + vrow) * NINP + C_VA + h * 128 + vd0; }
#define A_ISSUE(t, st) do { const size_t go = (size_t)(t) * 64 * NINP; LAS unsigned char* sb_ = L + (st) * AT_STAGE; \
        GLDS16(ksrc + go, sb_ + A_K1 + 1024 * w); GLDS16(ksrc + go + 512, sb_ + A_K2 + 1024 * w); \
        GLDS16(vsrc + go, sb_ + A_V + 2048 * w); GLDS16(vsrc + go + 64, sb_ + A_V + 2048 * w + 1024); } while (0)
    A_ISSUE(0, 0);
    DMA_WAIT_BAR();
    const int tbase = tq0 + r32 - 4 * hi;
#define A_K(c_, sub_, ks_) (*(const LAS bf16x8*)(kp + ((c_) ? A_K2 : A_K1) + ((sub_) * 4 + (ks_)) * 1024))
#define A_Q(c_, ks_) (*(const LAS bf16x8*)(q2p + ((c_) ? 0 : 4096) + (ks_) * 1024))
#define A_VF(sub_, s_, db_) tr_pair(vp + ((((sub_) * 2 + (s_)) * 2 + 0) * 4 + (db_)) * 512, vp + ((((sub_) * 2 + (s_)) * 2 + 1) * 4 + (db_)) * 512)
#define A_EL(xv_, i_, mh_, ls_, mx_) do { mx_ = fmaxf(mx_, xv_[i_]); const float e_ = __builtin_amdgcn_exp2f(xv_[i_] * (0.125f * LOG2E) - (mh_)); xv_[i_] = e_; ls_ += e_; } while (0)
#define A_SB() __builtin_amdgcn_sched_barrier(0)
    int tfast = (tq0 >= 176) ? ((tq0 - 176) >> 6) + 1 : 1; if (tfast > NT) tfast = NT; if (tfast < 1) tfast = 1;
    for (int t = 0; t < 1; ++t) {
        const int st = t & 1;
        if (t + 1 < NT) A_ISSUE(t + 1, st ^ 1);
        LAS unsigned char* kp = L + st * AT_STAGE + lane * 16;
        LAS unsigned char* vp = L + st * AT_STAGE + A_V + lane * 8;
#pragma unroll
        for (int sub = 0; sub < 2; ++sub) {
            const int s0 = 64 * t + 32 * sub;
            if (s0 <= tq0 + 31) {
                const bool band = s0 + 144 > tq0;
                bf16x8 p1[2], p2[2];
                { f32x16 x = (f32x16){};
#pragma unroll
                  for (int ks = 0; ks < 4; ++ks) x = MFMA32(*(const LAS bf16x8*)(kp + A_K1 + (sub * 4 + ks) * 1024), *(const LAS bf16x8*)(q2p + 4096 + ks * 1024), x);
                  if (band) { const int db_ = tbase - s0; const LAS float* lp = LUT + (191 - db_);
#pragma unroll
                    for (int i = 0; i < 16; ++i) { const int o_ = (i & 3) + 8 * (i >> 2); const float v_ = x[i] + lp[o_]; x[i] = (db_ < o_) ? -INFINITY : v_; } }
                  softmax_step_raw<4>(x, 0.125f * LOG2E, m1, l1, o1);
                  p1[0] = pack8(x, 0); p1[1] = pack8(x, 1); }
                { f32x16 x = (f32x16){};
#pragma unroll
                  for (int ks = 0; ks < 4; ++ks) x = MFMA32(*(const LAS bf16x8*)(kp + A_K2 + (sub * 4 + ks) * 1024), *(const LAS bf16x8*)(q2p + ks * 1024), x);
                  if (band) { const int db_ = tbase - s0; const LAS float* lp = LUT + (191 - db_);
#pragma unroll
                    for (int i = 0; i < 16; ++i) { const int o_ = (i & 3) + 8 * (i >> 2); const float v_ = x[i] + lp[o_]; x[i] = (db_ < o_) ? -INFINITY : v_; } }
                  softmax_step_raw<4>(x, 0.125f * LOG2E, m2, l2, o2);
                  p2[0] = pack8(x, 0); p2[1] = pack8(x, 1); }
#pragma unroll
                for (int s = 0; s < 2; ++s)
#pragma unroll
                    for (int db = 0; db < 4; ++db) {
                        const bf16x8 vf = tr_pair(vp + (((sub * 2 + s) * 2 + 0) * 4 + db) * 512, vp + (((sub * 2 + s) * 2 + 1) * 4 + db) * 512);
                        o1[db] = MFMA32(vf, p1[s], o1[db]); o2[db] = MFMA32(vf, p2[s], o2[db]); }
            }
        }
        DMA_WAIT_BAR();
    }
    for (int t = 1; t < tfast; ++t) {
        const int st = t & 1;
        if (t + 1 < NT) A_ISSUE(t + 1, st ^ 1);
        LAS unsigned char* kp = L + st * AT_STAGE + lane * 16;
        LAS unsigned char* vp = L + st * AT_STAGE + A_V + lane * 8;
        {
            float mx1 = -INFINITY, mx2 = -INFINITY;
            bf16x8 pa[2], pb[2], pc[2], pd[2];
            { f32x16 xa = (f32x16){}, xb = (f32x16){};
#pragma unroll
              for (int ks = 0; ks < 4; ++ks) xa = MFMA32(A_K(0, 0, ks), A_Q(0, ks), xa);
              A_SB();
#pragma unroll
              for (int ks = 0; ks < 4; ++ks) { xb = MFMA32(A_K(1, 0, ks), A_Q(1, ks), xb);
                  A_EL(xa, 4 * ks, m1, l1, mx1); A_EL(xa, 4 * ks + 1, m1, l1, mx1); A_EL(xa, 4 * ks + 2, m1, l1, mx1); A_EL(xa, 4 * ks + 3, m1, l1, mx1); A_SB(); }
              pa[0] = pack8(xa, 0); pa[1] = pack8(xa, 1);
              f32x16 xc = (f32x16){};
#pragma unroll
              for (int ks = 0; ks < 4; ++ks) { xc = MFMA32(A_K(0, 1, ks), A_Q(0, ks), xc);
                  A_EL(xb, 4 * ks, m2, l2, mx2); A_EL(xb, 4 * ks + 1, m2, l2, mx2); A_EL(xb, 4 * ks + 2, m2, l2, mx2); A_EL(xb, 4 * ks + 3, m2, l2, mx2); A_SB(); }
              pb[0] = pack8(xb, 0); pb[1] = pack8(xb, 1);
              A_SB();
#pragma unroll
              for (int i = 0; i < 8; ++i) { o1[i & 3] = MFMA32(A_VF(0, i >> 2, i & 3), pa[i >> 2], o1[i & 3]); A_EL(xc, 2 * i, m1, l1, mx1); A_EL(xc, 2 * i + 1, m1, l1, mx1); A_SB(); }
              pc[0] = pack8(xc, 0); pc[1] = pack8(xc, 1); }
            { f32x16 xd = (f32x16){};
#pragma unroll
              for (int ks = 0; ks < 4; ++ks) xd = MFMA32(A_K(1, 1, ks), A_Q(1, ks), xd);
              A_SB();
#pragma unroll
              for (int i = 0; i < 8; ++i) { o2[i & 3] = MFMA32(A_VF(0, i >> 2, i & 3), pb[i >> 2], o2[i & 3]); A_EL(xd, 2 * i, m2, l2, mx2); A_EL(xd, 2 * i + 1, m2, l2, mx2); A_SB(); }
              pd[0] = pack8(xd, 0); pd[1] = pack8(xd, 1); }
            A_SB();
#pragma unroll
            for (int i = 0; i < 8; ++i) { const bf16x8 vf = A_VF(1, i >> 2, i & 3); o1[i & 3] = MFMA32(vf, pc[i >> 2], o1[i & 3]); o2[i & 3] = MFMA32(vf, pd[i >> 2], o2[i & 3]); }
            A_SB();
            mx1 = xhalf_max(mx1) * (0.125f * LOG2E); mx2 = xhalf_max(mx2) * (0.125f * LOG2E);
            if (__any(mx1 > m1 + 8.f)) { const float mnew = fmaxf(m1, mx1), f = __builtin_amdgcn_exp2f(m1 - mnew); l1 *= f;
#pragma unroll
                for (int d = 0; d < 4; ++d) o1[d] *= f;
                m1 = mnew; }
            if (__any(mx2 > m2 + 8.f)) { const float mnew = fmaxf(m2, mx2), f = __builtin_amdgcn_exp2f(m2 - mnew); l2 *= f;
#pragma unroll
                for (int d = 0; d < 4; ++d) o2[d] *= f;
                m2 = mnew; }
        }
        DMA_WAIT_BAR();
    }
    for (int t = tfast; t < NT; ++t) {
        const int st = t & 1;
        if (t + 1 < NT) A_ISSUE(t + 1, st ^ 1);
        LAS unsigned char* kp = L + st * AT_STAGE + lane * 16;
        LAS unsigned char* vp = L + st * AT_STAGE + A_V + lane * 8;
#pragma unroll
        for (int sub = 0; sub < 2; ++sub) {
            const int s0 = 64 * t + 32 * sub;
            if (s0 <= tq0 + 31) {
                const bool band = s0 + 144 > tq0;
                bf16x8 p1[2], p2[2];
                { f32x16 x = (f32x16){};
#pragma unroll
                  for (int ks = 0; ks < 4; ++ks) x = MFMA32(*(const LAS bf16x8*)(kp + A_K1 + (sub * 4 + ks) * 1024), *(const LAS bf16x8*)(q2p + 4096 + ks * 1024), x);
                  if (band) { const int db_ = tbase - s0; const LAS float* lp = LUT + (191 - db_);
#pragma unroll
                    for (int i = 0; i < 16; ++i) { const int o_ = (i & 3) + 8 * (i >> 2); const float v_ = x[i] + lp[o_]; x[i] = (db_ < o_) ? -INFINITY : v_; } }
                  softmax_step_raw<4>(x, 0.125f * LOG2E, m1, l1, o1);
                  p1[0] = pack8(x, 0); p1[1] = pack8(x, 1); }
                { f32x16 x = (f32x16){};
#pragma unroll
                  for (int ks = 0; ks < 4; ++ks) x = MFMA32(*(const LAS bf16x8*)(kp + A_K2 + (sub * 4 + ks) * 1024), *(const LAS bf16x8*)(q2p + ks * 1024), x);
                  if (band) { const int db_ = tbase - s0; const LAS float* lp = LUT + (191 - db_);
#pragma unroll
                    for (int i = 0; i < 16; ++i) { const int o_ = (i & 3) + 8 * (i >> 2); const float v_ = x[i] + lp[o_]; x[i] = (db_ < o_) ? -INFINITY : v_; } }
                  softmax_step_raw<4>(x, 0.125f * LOG2E, m2, l2, o2);
                  p2[0] = pack8(x, 0); p2[1] = pack8(x, 1); }
#pragma unroll
                for (int s = 0; s < 2; ++s)
#pragma unroll
                    for (int db = 0; db < 4; ++db) {
                        const bf16x8 vf = tr_pair(vp + (((sub * 2 + s) * 2 + 0) * 4 + db) * 512, vp + (((sub * 2 + s) * 2 + 1) * 4 + db) * 512);
                        o1[db] = MFMA32(vf, p1[s], o1[db]); o2[db] = MFMA32(vf, p2[s], o2[db]); }
            }
        }
        DMA_WAIT_BAR();
    }
#undef A_K
#undef A_Q
#undef A_VF
#undef A_EL
#undef A_SB
#undef A_ISSUE
    l1 = xhalf_sum(l1); l2 = xhalf_sum(l2);
    const float i1 = 1.f / l1, i2 = lam / l2;
    float ss = 0.f;
#pragma unroll
    for (int d = 0; d < 4; ++d)
#pragma unroll
        for (int i = 0; i < 16; ++i) { const float o = o1[d][i] * i1 - o2[d][i] * i2; o1[d][i] = o; ss += o * o; }
    ss = xhalf_sum(ss);
    const float rs = rsqrtf(ss * (1.f / 128.f) + EPS) * 0.8f;
    int lane2 = mk_lane(); asm volatile("" : "+v"(lane2));
    const int hie = lane2 >> 5; const size_t row = rowb + tq0 + (lane2 & 31);
    unsigned long long zq[16];
#pragma unroll
    for (int i = 0; i < 16; ++i) zq[i] = *(const GAS unsigned long long*)(F.P + row * NINP + C_ZA + h * 128 + 32 * (i >> 2) + 8 * (i & 3) + 4 * hie);
    a_load_q(F, nb, nh, nqb, qn);
#pragma unroll
    for (int d = 0; d < 4; ++d)
#pragma unroll
        for (int g = 0; g < 4; ++g) { const int d0 = 32 * d + 8 * g + 4 * hie;
            const unsigned long long zz = zq[4 * d + g];
            const f32x4 gg = *(const GAS f32x4*)(F.subln_g + d0);
            const float r0 = o1[d][4 * g] * rs * gg.x * silu(bflo((unsigned)zz)), r1 = o1[d][4 * g + 1] * rs * gg.y * silu(bfhi((unsigned)zz));
            const float r2 = o1[d][4 * g + 2] * rs * gg.z * silu(bflo((unsigned)(zz >> 32))), r3 = o1[d][4 * g + 3] * rs * gg.w * silu(bfhi((unsigned)(zz >> 32)));
            *(GAS unsigned long long*)(F.O + row * DO + h * 128 + d0) = (unsigned long long)cvtpk(r0, r1) | ((unsigned long long)cvtpk(r2, r3) << 32); }
}

constexpr int IX_STAGE = 16384;
__device__ __forceinline__ void idx_load_q(Frame& F, int b, int blk, bf16x8 (&afn)[4], v4u (&wn)[2]) {
    int lane = mk_lane(), w = F.wave; asm volatile("" : "+v"(lane), "+s"(w));
    const int r32 = lane & 31, hi = lane >> 5, tokm = (r32 >> 2) & 1, head = (r32 & 3) + 4 * (r32 >> 3); const size_t rowb = (size_t)b * T; const int t0 = 16 * blk;
    const bf16* qr = F.P + (rowb + t0 + 2 * w + tokm) * NINP + C_IQ + head * 64 + 8 * hi;
#pragma unroll
    for (int ks = 0; ks < 4; ++ks) afn[ks] = *(const GAS bf16x8*)(qr + 16 * ks);
    const bf16* wr = F.P + (rowb + t0 + 2 * w + hi) * NINP + C_IW;
    wn[0] = *(const GAS v4u*)wr; wn[1] = *(const GAS v4u*)(wr + 8);
}
__device__ __forceinline__ void idx_issue3(Frame& F, int b, int blk) {
    LAS unsigned char* L = F.lds + RING_OFF;
    int lane = mk_lane(), w = F.wave; asm volatile("" : "+v"(lane), "+s"(w));
    const int nst = (16 * blk + 16 + 127) >> 7;
    const bf16* isrc = F.IKn + ((size_t)b * T + 32 * (w >> 1) + (lane & 31)) * 64 + 16 * (2 * (w & 1)) + 8 * (lane >> 5);
#pragma unroll
    for (int s = 0; s < 3; ++s) { const size_t go = (size_t)(s < nst ? s : nst - 1) * 128 * 64; LAS unsigned char* sb_ = L + s * 16384 + 2048 * w; GLDS16(isrc + go, sb_); GLDS16(isrc + go + 16, sb_ + 1024); }
}
__device__ __forceinline__ void idx_unit(Frame& F, int b, int blk, bf16x8 (&afn)[4], v4u (&wn)[2], int nb, int nblk) {
    LAS unsigned char* L = F.lds + RING_OFF;
    int lane = mk_lane(), w = F.wave; asm volatile("" : "+v"(lane), "+s"(w));
    const int r32 = lane & 31, hi = lane >> 5;
    const int t0 = 16 * blk; const size_t rowb = (size_t)b * T;
    bf16x8 af[4]; float wq[16];
    { const v4u w0 = wn[0], w1 = wn[1];
#pragma unroll
      for (int ks = 0; ks < 4; ++ks) af[ks] = afn[ks];
      const float sc_ = 0.25f * 0.125f;
      wq[0] = bflo(w0.x) * sc_; wq[1] = bfhi(w0.x) * sc_; wq[2] = bflo(w0.y) * sc_; wq[3] = bfhi(w0.y) * sc_; wq[4] = bflo(w0.z) * sc_; wq[5] = bfhi(w0.z) * sc_; wq[6] = bflo(w0.w) * sc_; wq[7] = bfhi(w0.w) * sc_;
      wq[8] = bflo(w1.x) * sc_; wq[9] = bfhi(w1.x) * sc_; wq[10] = bflo(w1.y) * sc_; wq[11] = bfhi(w1.y) * sc_; wq[12] = bflo(w1.z) * sc_; wq[13] = bfhi(w1.z) * sc_; wq[14] = bflo(w1.w) * sc_; wq[15] = bfhi(w1.w) * sc_; }
    const int nst = (t0 + 16 + 127) >> 7;
    const bf16* isrc = F.IKn + (rowb + 32 * (w >> 1) + r32) * 64 + 16 * (2 * (w & 1)) + 8 * hi;
#define I_ISSUE(st_, buf_) do { const size_t go = (size_t)(st_) * 128 * 64; LAS unsigned char* sb_ = L + (buf_) * IX_STAGE + 2048 * w; GLDS16(isrc + go, sb_); GLDS16(isrc + go + 16, sb_ + 1024); } while (0)
#define I_CLAMP(s_) ((s_) < nst ? (s_) : nst - 1)
    asm volatile("s_waitcnt vmcnt(4)" ::: "memory"); __syncthreads();
#pragma unroll
    for (int ks = 0; ks < 4; ++ks) asm volatile("" : "+v"(af[ks]));
#pragma unroll
    for (int i = 0; i < 16; ++i) asm volatile("" : "+v"(wq[i]));
    float sc[64];
#pragma unroll
    for (int st = 0; st < 16; ++st) {
        if (st < nst) {
            I_ISSUE(I_CLAMP(st + 3), (st + 3) & 3);
            LAS unsigned char* kp = L + (st & 3) * IX_STAGE + lane * 16;
            { f32x16 pa = (f32x16){};
#pragma unroll
              for (int ks = 0; ks < 4; ++ks) pa = MFMA32(af[ks], *(const LAS bf16x8*)(kp + ks * 1024), pa);
              __builtin_amdgcn_sched_barrier(0);
#pragma unroll
              for (int j = 1; j < 4; ++j) { f32x16 ca = (f32x16){}; float s0_ = 0.f, s1_ = 0.f;
#pragma unroll
                  for (int ks = 0; ks < 4; ++ks) { ca = MFMA32(af[ks], *(const LAS bf16x8*)(kp + (j * 4 + ks) * 1024), ca);
                      s0_ += wq[4 * ks] * fmaxf(pa[4 * ks], 0.f); s1_ += wq[4 * ks + 1] * fmaxf(pa[4 * ks + 1], 0.f); s0_ += wq[4 * ks + 2] * fmaxf(pa[4 * ks + 2], 0.f); s1_ += wq[4 * ks + 3] * fmaxf(pa[4 * ks + 3], 0.f);
                      __builtin_amdgcn_sched_barrier(0); }
                  sc[4 * st + j - 1] = s0_ + s1_; pa = ca; }
              float s0_ = 0.f, s1_ = 0.f;
#pragma unroll
              for (int i = 0; i < 16; i += 2) { s0_ += wq[i] * fmaxf(pa[i], 0.f); s1_ += wq[i + 1] * fmaxf(pa[i + 1], 0.f); }
              sc[4 * st + 3] = s0_ + s1_; }
            asm volatile("s_waitcnt vmcnt(4)" ::: "memory"); __syncthreads();
        } else {
#pragma unroll
            for (int j = 0; j < 4; ++j) sc[4 * st + j] = 0.f;
        }
    }
    asm volatile("s_waitcnt vmcnt(0)" ::: "memory");
#undef I_CLAMP
#undef I_ISSUE
    idx_issue3(F, nb, nblk);
    idx_load_q(F, nb, nblk, afn, wn);
    const int t = t0 + 2 * w + hi, n = t + 1;
    unsigned m0 = 0u, m1 = 0u;
    if (t0 + 15 < TOPK) {
#pragma unroll
        for (int i = 0; i < 8; ++i) { const unsigned long long bm = __ballot(32 * i + r32 < n); m0 = (lane == i) ? (unsigned)bm : m0; m1 = (lane == i) ? (unsigned)(bm >> 32) : m1; }
    } else {
        unsigned key[64];
#pragma unroll
        for (int i = 0; i < 64; ++i) key[i] = (32 * i + r32 < n) ? skey(sc[i]) : 0u;
        const int ng = (t0 + 16 + 255) >> 8;
#define HALF_COUNTS(cl_, c0_, c1_) do { int x_ = (cl_); \
            x_ += __builtin_amdgcn_update_dpp(0, x_, 0x111, 0xf, 0xf, true); x_ += __builtin_amdgcn_update_dpp(0, x_, 0x112, 0xf, 0xf, true); \
            x_ += __builtin_amdgcn_update_dpp(0, x_, 0x114, 0xf, 0xf, true); x_ += __builtin_amdgcn_update_dpp(0, x_, 0x118, 0xf, 0xf, true); \
            c0_ = __builtin_amdgcn_readlane(x_, 15) + __builtin_amdgcn_readlane(x_, 31); c1_ = __builtin_amdgcn_readlane(x_, 47) + __builtin_amdgcn_readlane(x_, 63); } while (0)
        unsigned kmx = 0u, kmn = 0xffffffffu;
#pragma unroll
        for (int g = 0; g < 8; ++g) if (g < ng) {
#pragma unroll
            for (int i = 8 * g; i < 8 * g + 8; ++i) { kmx = max(kmx, key[i]); kmn = min(kmn, (32 * i + r32 < n) ? key[i] : 0xffffffffu); } }
#define IX_SWZ(pat_) do { kmx = max(kmx, (unsigned)__builtin_amdgcn_ds_swizzle((int)kmx, (pat_))); kmn = min(kmn, (unsigned)__builtin_amdgcn_ds_swizzle((int)kmn, (pat_))); } while (0)
        IX_SWZ(0x041f); IX_SWZ(0x081f); IX_SWZ(0x101f); IX_SWZ(0x201f); IX_SWZ(0x401f);
#undef IX_SWZ
        const unsigned dif = kmx ^ kmn;
        int hb = 31 - __clz((int)(dif | 1u));
        unsigned thr = (hb >= 31) ? 0u : (kmx & ~((2u << hb) - 1u));
        hb = max(hb, __shfl_xor(hb, 32));
        hb = __builtin_amdgcn_readfirstlane(hb);
        bool done = false;
        for (int bit = hb; bit >= 0; --bit) {
            const unsigned cand = thr | (1u << bit); int cl = 0;
#pragma unroll
            for (int g = 0; g < 8; ++g) if (g < ng) {
#pragma unroll
                for (int i = 8 * g; i < 8 * g + 8; ++i) cl += (key[i] >= cand) ? 1 : 0; }
            int c0, c1; HALF_COUNTS(cl, c0, c1);
            const int cnt = hi ? c1 : c0;
            if (!done && cnt >= TOPK) { thr = cand; done = (cnt == TOPK); }
            if (__ballot(!done) == 0ull) break;
        }
        int g0, g1;
        { int cl = 0;
#pragma unroll
          for (int g = 0; g < 8; ++g) if (g < ng) {
#pragma unroll
              for (int i = 8 * g; i < 8 * g + 8; ++i) cl += (key[i] > thr) ? 1 : 0; }
          HALF_COUNTS(cl, g0, g1); }
        const int need = TOPK - (hi ? g1 : g0); int e0 = 0, e1 = 0; const unsigned lt = (1u << r32) - 1u;
#pragma unroll
        for (int g = 0; g < 8; ++g) if (g < ng) {
#pragma unroll
            for (int i = 8 * g; i < 8 * g + 8; ++i) { const bool gt = key[i] > thr, eq = key[i] == thr; const unsigned long long meq = __ballot(eq);
                const unsigned mq = hi ? (unsigned)(meq >> 32) : (unsigned)meq; const int seen = hi ? e1 : e0;
                const bool take = gt || (eq && (seen + __popc(mq & lt)) < need); const unsigned long long bm = __ballot(take);
                m0 = (lane == i) ? (unsigned)bm : m0; m1 = (lane == i) ? (unsigned)(bm >> 32) : m1;
                e0 += __popc((unsigned)meq); e1 += __popc((unsigned)(meq >> 32)); } }
#undef HALF_COUNTS
    }
    F.BM[(rowb + t0 + 2 * w) * 64 + lane] = m0; F.BM[(rowb + t0 + 2 * w + 1) * 64 + lane] = m1;
}

constexpr int AT_LUTB = AT_LUT + 1024;
__device__ __forceinline__ void b_load_q(Frame& F, int b, int blk, bf16x8 (&qn)[16]) {
    int lane = mk_lane(), w = F.wave; asm volatile("" : "+v"(lane), "+s"(w));
    const bf16* qrow = F.P + ((size_t)b * T + 32 * blk + (lane & 31)) * NINP + C_QB + w * 256 + 8 * (lane >> 5);
#pragma unroll
    for (int ks = 0; ks < 16; ++ks) qn[ks] = *(const GAS bf16x8*)(qrow + 16 * ks);
}
__device__ __forceinline__ void b_unit(Frame& F, int b, int blk, bf16x8 (&qn)[16], int nb, int nblk) {
    LAS unsigned char* L = F.lds + RING_OFF;
    int lane = mk_lane(), w = F.wave; asm volatile("" : "+v"(lane), "+s"(w));
    const int r32 = lane & 31, hi = lane >> 5;
    const int t0 = 32 * blk; const size_t rowb = (size_t)b * T; const size_t row = rowb + t0 + r32;
    const LAS float* LUT = (const LAS float*)(L + AT_LUTB) + w * 256;
    __syncthreads();
    bf16x8 qf[8];
    LAS unsigned char* qpk = L + AT_Q2 + w * 8192 + lane * 16;
#pragma unroll
    for (int ks = 0; ks < 8; ++ks) { qf[ks] = qn[ks]; *(LAS bf16x8*)(qpk + ks * 1024) = qn[8 + ks]; }
    f32x16 o[8];
#pragma unroll
    for (int d = 0; d < 8; ++d) o[d] = (f32x16){};
    float mh = -1e30f, ls = 0.f;
    const int NS = (blk + 2) >> 1;
    const bf16* tsrc;
    { const int c = lane >> 4, a = (lane >> 2) & 3, bb = (lane & 3) ^ c;
      tsrc = F.CKVn + (rowb + 32 * (w >> 2) + 4 * bb + a) * 256 + 32 * (2 * (w & 3)) + 8 * c; }
#define B_ISSUE(st_, buf_) do { const size_t go = (size_t)(st_) * 64 * 256; LAS unsigned char* sb_ = L + (buf_) * AT_STAGE + (w >> 2) * 16384 + (w & 3) * 4096; \
        GLDS16(tsrc + go, sb_); GLDS16(tsrc + go + 4096, sb_ + 1024); GLDS16(tsrc + go + 32, sb_ + 2048); GLDS16(tsrc + go + 4096 + 32, sb_ + 3072); } while (0)
    B_ISSUE(0, 0);
    DMA_WAIT_BAR();
    const int tbase = t0 + r32 - 4 * hi;
    const unsigned* bmrow = F.BM + row * 64;
    const int ka = r32 & 3, kb = (r32 >> 2) & 3;
    const int kpe = (r32 >> 4) * 1024 + hi * 256 + (4 * ka + (kb ^ hi)) * 16, kpo = (r32 >> 4) * 1024 + (2 + hi) * 256 + (4 * ka + (kb ^ (2 + hi))) * 16;
    const int q4 = (lane >> 2) & 3, tc = 2 * ((lane >> 4) & 1) + ((lane & 3) >> 1);
    const int vp0 = tc * 256 + (4 * q4 + (hi ^ tc)) * 16 + 8 * (lane & 1), vp1 = tc * 256 + (4 * q4 + ((2 + hi) ^ tc)) * 16 + 8 * (lane & 1);
#pragma unroll
    for (int ks = 0; ks < 8; ++ks) asm volatile("" : "+v"(qf[ks]));
    unsigned long long wcur = *(const GAS unsigned long long*)bmrow;
    asm volatile("" : "+v"(wcur));
#define KRD(tau_, ks_) (*(const LAS bf16x8*)(sb + (tau_) * 16384 + ((ks_) >> 1) * 2048 + (((ks_) & 1) ? kpo : kpe)))
#define QRD(ks_) (*(const LAS bf16x8*)(qpk + ((ks_) - 8) * 1024))
#define VRD(tau_, s_, cb_) tr_pair(sb + (tau_) * 16384 + (cb_) * 2048 + (s_) * 1024 + vp0, sb + (tau_) * 16384 + (cb_) * 2048 + (s_) * 1024 + vp1)
#define SB0() __builtin_amdgcn_sched_barrier(0)
#define B_QK(xv_, tau_) do { xv_ = (f32x16){}; _Pragma("unroll") for (int ks = 0; ks < 16; ++ks) xv_ = MFMA32(KRD(tau_, ks), (ks < 8) ? qf[ks & 7] : QRD(ks), xv_); } while (0)
#define B_EL(xv_, i_, lp_, wsel_, mx_) do { const int o_ = ((i_) & 3) + 8 * ((i_) >> 2); const float v_ = xv_[i_] * (0.0625f * LOG2E) + (lp_)[o_]; const float m_ = ((wsel_) & (1u << o_)) ? v_ : -INFINITY; \
        mx_ = fmaxf(mx_, m_); const float e_ = __builtin_amdgcn_exp2f(m_ - mh); xv_[i_] = e_; ls += e_; } while (0)
    {
        LAS unsigned char* sb = L; f32x16 x; B_QK(x, 0);
        const unsigned wsel = (unsigned)wcur >> (4 * hi); const int db_ = tbase; const LAS float* lp_ = LUT + (db_ > 191 ? 0 : 191 - db_); float mt_ = -INFINITY;
#pragma unroll
        for (int i = 0; i < 16; ++i) { const int o_ = (i & 3) + 8 * (i >> 2); const float v_ = x[i] * (0.0625f * LOG2E) + lp_[o_]; mt_ = fmaxf(mt_, (wsel & (1u << o_)) ? v_ : -INFINITY); }
        mt_ = xhalf_max(mt_); mh = (mt_ > -1e30f) ? mt_ : 0.f;
    }
    for (int st = 0; st < NS; ++st) {
        unsigned long long wnext = 0ull;
        if (st + 1 < NS) { wnext = *(const GAS unsigned long long*)(bmrow + 2 * (st + 1)); B_ISSUE(st + 1, (st + 1) & 1); }
        LAS unsigned char* sb = L + (st & 1) * AT_STAGE;
        const unsigned wsel0 = (unsigned)wcur >> (4 * hi), wsel1 = (unsigned)(wcur >> 32) >> (4 * hi);
        const int db0 = tbase - 64 * st, db1 = db0 - 32;
        const LAS float* lp0 = LUT + (db0 > 191 ? 0 : 191 - db0); const LAS float* lp1 = LUT + (db1 > 191 ? 0 : 191 - db1);
        f32x16 x0, x1; float mx = -INFINITY;
        B_QK(x0, 0);
        SB0();
        x1 = (f32x16){};
        { bf16x8 kb[2], qb[2]; kb[0] = KRD(1, 0);
#pragma unroll
          for (int ks = 0; ks < 16; ++ks) { if (ks + 1 < 16) { kb[(ks + 1) & 1] = KRD(1, ks + 1); if (ks + 1 >= 8) qb[(ks + 1) & 1] = QRD(ks + 1); }
              x1 = MFMA32(kb[ks & 1], (ks < 8) ? qf[ks & 7] : qb[ks & 1], x1); B_EL(x0, ks, lp0, wsel0, mx); SB0(); } }
        bf16x8 pa[2]; pa[0] = pack8(x0, 0); pa[1] = pack8(x0, 1);
        SB0();
        { bf16x8 vb[2]; vb[0] = VRD(0, 0, 0);
#pragma unroll
          for (int i = 0; i < 16; ++i) { if (i + 1 < 16) vb[(i + 1) & 1] = VRD(0, (i + 1) >> 3, (i + 1) & 7);
              o[i & 7] = MFMA32(vb[i & 1], pa[i >> 3], o[i & 7]); B_EL(x1, i, lp1, wsel1, mx); SB0(); } }
        bf16x8 pb[2]; pb[0] = pack8(x1, 0); pb[1] = pack8(x1, 1);
        SB0();
#pragma unroll
        for (int s = 0; s < 2; ++s)
#pragma unroll
            for (int cb = 0; cb < 8; ++cb) o[cb] = MFMA32(VRD(1, s, cb), pb[s], o[cb]);
        SB0();
        mx = xhalf_max(mx);
        if (__any(mx > mh + 8.f)) {
            const float mnew = fmaxf(mh, mx), f = __builtin_amdgcn_exp2f(mh - mnew); ls *= f;
#pragma unroll
            for (int d = 0; d < 8; ++d) o[d] *= f;
            mh = mnew; }
        DMA_WAIT_BAR();
        asm volatile("" : "+v"(wnext)); wcur = wnext;
    }
#undef B_EL
#undef B_QK
#undef KRD
#undef QRD
#undef VRD
#undef SB0
#undef B_ISSUE
    ls = xhalf_sum(ls);
    const float inv = 1.f / ls;
    int lane2 = mk_lane(); asm volatile("" : "+v"(lane2));
    const int r32e = lane2 & 31, hie = lane2 >> 5; const size_t rowe = rowb + t0 + r32e;
    unsigned long long zz[16];
#pragma unroll
    for (int i = 0; i < 16; ++i) zz[i] = *(const GAS unsigned long long*)(F.P + rowe * NINP + C_ZB + w * 128 + 32 * (i >> 2) + 8 * (i & 3) + 4 * hie);
    b_load_q(F, nb, nblk, qn);
    LAS unsigned char* ofp = L + w * 16384 + lane2 * 16;
#pragma unroll
    for (int cb = 0; cb < 8; ++cb) { o[cb] *= inv; *(LAS bf16x8*)(ofp + (2 * cb) * 1024) = pack8(o[cb], 0); *(LAS bf16x8*)(ofp + (2 * cb + 1) * 1024) = pack8(o[cb], 1); }
    const bf16* wu = F.WuvT + (size_t)w * 4 * 16 * 512 + lane2 * 8;
#pragma unroll
    for (int mt = 0; mt < 4; ++mt) {
        bf16x8 wa[16];
#pragma unroll
        for (int i = 0; i < 16; ++i) wa[i] = *(const GAS bf16x8*)(wu + (size_t)(mt * 16 + i) * 512);
        __builtin_amdgcn_sched_barrier(0);
        f32x16 acc = (f32x16){};
#pragma unroll
        for (int i = 0; i < 16; ++i) acc = MFMA32(wa[i], *(const LAS bf16x8*)(ofp + i * 1024), acc);
#pragma unroll
        for (int g = 0; g < 4; ++g) { const int d0 = 32 * mt + 8 * g + 4 * hie; const unsigned long long z_ = zz[4 * mt + g];
            const float r0 = acc[4 * g] * silu(bflo((unsigned)z_)), r1 = acc[4 * g + 1] * silu(bfhi((unsigned)z_));
            const float r2 = acc[4 * g + 2] * silu(bflo((unsigned)(z_ >> 32))), r3 = acc[4 * g + 3] * silu(bfhi((unsigned)(z_ >> 32)));
            *(GAS unsigned long long*)(F.O + rowe * DO + 1024 + w * 128 + d0) = (unsigned long long)cvtpk(r0, r1) | ((unsigned long long)cvtpk(r2, r3) << 32); }
        __builtin_amdgcn_sched_barrier(0);
    }
}

#ifndef NAIVE_B
#define NAIVE_B 0
#endif
__device__ __forceinline__ void p3_attention_mixed(Frame& F) {
    const int gw = F.vcu * NWAVES + F.wave, NGW = F.G * NWAVES, lane = mk_lane();
    float d1 = F.lq1[lane] * F.lk1[lane], d2 = F.lq2[lane] * F.lk2[lane];
    const float lam = __expf(wave_sum(d1)) - __expf(wave_sum(d2)) + 0.2f;
    for (int i = (F.wave * 64 + mk_lane()); i < 8 * 256; i += NWAVES * 64) { const int hh = i >> 8, dist = 191 - (i & 255);
        ((LAS float*)(F.lds + RING_OFF + AT_LUTB))[i] = (dist >= 0 && dist < 128) ? (F.rel_bias[t5_bucket(dist) * 16 + 8 + hh] - F.rel_bias[31 * 16 + 8 + hh]) * LOG2E : 0.f; }
    for (int rep_ = 0; rep_ < (REPEAT_PHASE == 41 ? 2 : 1); ++rep_)
    { bf16x8 qa[8];
      { const int u0 = 2 * F.vcu; if (u0 < 1024) { const int p = u0 >> 1, bh = p >> 2; a_load_q(F, bh >> 3, bh & 7, 7 - (p & 3), qa); } }
#pragma unroll 1
      for (int u = 2 * F.vcu; u < 1024; ) { const int un = u + ((u & 1) ? 2 * F.G - 1 : 1);
          const int p = u >> 1, bh = p >> 2, j = p & 3, qb = (u & 1) ? j : 7 - j; const bool hn = un < 1024; const int pn = un >> 1, bhn = pn >> 2, jn = pn & 3;
          a_unit(F, bh >> 3, bh & 7, qb, lam, qa, hn ? (bhn >> 3) : (bh >> 3), hn ? (bhn & 7) : (bh & 7), hn ? ((un & 1) ? jn : 7 - jn) : qb);
          u = un; } }
#if NAIVE_B
    __syncthreads();
    LAS unsigned char* wl = F.lds + RING_OFF + F.wave * 16384;
    for (int task = gw; task < M; task += NGW) { const int b = task / T, tt = task % T; const int t = (b & 1) ? (T - 1 - tt) : tt; naive_dsa(F, b, t, wl); }
#else
    for (int rep_ = 0; rep_ < (REPEAT_PHASE == 42 ? 2 : 1); ++rep_)
    { bf16x8 afn[4]; v4u wn[2];
      { const int u0 = 4 * F.vcu; if (u0 < 2048) { const int p = u0 >> 2; __syncthreads(); idx_issue3(F, p >> 5, 2 * (63 - (p & 31))); idx_load_q(F, p >> 5, 2 * (63 - (p & 31)), afn, wn); } }
#pragma unroll 1
      for (int u = 4 * F.vcu; u < 2048; ) { const int un = u + (((u & 3) == 3) ? 4 * F.G - 3 : 1);
          const int p = u >> 2, b = p >> 5, j = p & 31, blk = 2 * ((u & 2) ? j : 63 - j) + (u & 1); const bool hn = un < 2048; const int pn = un >> 2, jn = pn & 31;
          idx_unit(F, b, blk, afn, wn, hn ? (pn >> 5) : b, hn ? 2 * ((un & 2) ? jn : 63 - jn) + (un & 1) : blk);
          u = un; } }
    asm volatile("s_waitcnt vmcnt(0)" ::: "memory"); __syncthreads();
    { bf16x8 qn[16];
      { const int u0 = 2 * F.vcu; if (u0 < 1024) { const int p = u0 >> 1; b_load_q(F, p >> 5, 63 - (p & 31), qn); } }
#pragma unroll 1
      for (int u = 2 * F.vcu; u < 1024; ) { const int un = u + ((u & 1) ? 2 * F.G - 1 : 1);
          const int p = u >> 1, b = p >> 5, j = p & 31, pn = un >> 1, jn = pn & 31;
          const int bk = (u & 1) ? j : 63 - j; const bool hn = un < 1024; b_unit(F, b, bk, qn, hn ? (pn >> 5) : b, hn ? ((un & 1) ? jn : 63 - jn) : bk);
          u = un; } }
#endif
}

__device__ __forceinline__ void p5_final(Frame& F) {
    const int gw = F.vcu * NWAVES + F.wave, NGW = F.G * NWAVES, lane = mk_lane();
    for (int m = gw; m < M; m += NGW) {
        const GAS v4u* yr = (const GAS v4u*)(F.Y + (size_t)m * D) + lane; v4u y[4]; float s = 0.f;
#pragma unroll
        for (int j = 0; j < 4; ++j) { y[j] = yr[64 * j];
            const float a0 = bflo(y[j].x), a1 = bfhi(y[j].x), a2 = bflo(y[j].y), a3 = bfhi(y[j].y), a4 = bflo(y[j].z), a5 = bfhi(y[j].z), a6 = bflo(y[j].w), a7 = bfhi(y[j].w);
            s += (a0 * a0 + a1 * a1) + (a2 * a2 + a3 * a3) + (a4 * a4 + a5 * a5) + (a6 * a6 + a7 * a7); }
        const float rstd = rsqrtf(wave_sum(s) * (1.f / D) + EPS);
#pragma unroll
        for (int j = 0; j < 4; ++j) { const size_t e = (size_t)(64 * j + lane) * 8;
            const f32x4 x0 = *(const GAS f32x4*)(F.x + (size_t)m * D + e), x1 = *(const GAS f32x4*)(F.x + (size_t)m * D + e + 4);
            const f32x4 g0 = *(const GAS f32x4*)(F.g_post + e), g1 = *(const GAS f32x4*)(F.g_post + e + 4);
            f32x4 r0, r1;
            r0.x = x0.x + bflo(y[j].x) * rstd * g0.x; r0.y = x0.y + bfhi(y[j].x) * rstd * g0.y; r0.z = x0.z + bflo(y[j].y) * rstd * g0.z; r0.w = x0.w + bfhi(y[j].y) * rstd * g0.w;
            r1.x = x1.x + bflo(y[j].z) * rstd * g1.x; r1.y = x1.y + bfhi(y[j].z) * rstd * g1.y; r1.z = x1.z + bflo(y[j].w) * rstd * g1.z; r1.w = x1.w + bfhi(y[j].w) * rstd * g1.w;
            *(GAS f32x4*)(F.out + (size_t)m * D + e) = r0; *(GAS f32x4*)(F.out + (size_t)m * D + e + 4) = r1; }
    }
}

struct Args { const float* in[14]; float* out; unsigned char* ws; int ph_lo, ph_hi, li, pad; };
__global__ void __launch_bounds__(NWAVES * 64, 2) fwd(Args args) {
    extern __shared__ __attribute__((aligned(16))) unsigned char lds[];
    Frame F;
    F.lds = (LAS unsigned char*)lds;
    F.MISC = (volatile LAS unsigned*)(F.lds + MISC_OFF);
    F.wave = __builtin_amdgcn_readfirstlane((int)(threadIdx.x >> 6));
    F.G = gridDim.x; { const int bx = blockIdx.x; F.vcu = (F.G % 8 == 0) ? (bx % 8) * (F.G / 8) + bx / 8 : bx; }
    unsigned char* ws = args.ws;
    F.ctl = (gu32*)(ws + WS_CTL);
    F.x = args.in[0]; F.g_pre = args.in[1]; F.w_in = args.in[2]; F.lq1 = args.in[3]; F.lk1 = args.in[4]; F.lq2 = args.in[5]; F.lk2 = args.in[6]; F.subln_g = args.in[7];
    F.kvn_g = args.in[8]; F.ikn_g = args.in[9]; F.w_uv = args.in[10]; F.rel_bias = args.in[11]; F.w_out = args.in[12]; F.g_post = args.in[13]; F.out = args.out;
    F.WinT = (bf16*)(ws + WS_WIN); F.WoutT = (bf16*)(ws + WS_WOUT); F.WuvT = (bf16*)(ws + WS_WUV); F.CKVn = (bf16*)(ws + WS_CKV); F.IKn = (bf16*)(ws + WS_IK);
    F.H = (bf16*)(ws + WS_H); F.O = (bf16*)(ws + WS_H); F.P = (bf16*)(ws + WS_P); F.Y = (bf16*)(ws + WS_P); F.BM = (unsigned*)(ws + WS_BM);
    for (int u = F.wave * 64 + mk_lane(); u < (LDS_BYTES - LDSCTL_OFF) / 4; u += NWAVES * 64) ((LAS unsigned*)(F.lds + LDSCTL_OFF))[u] = 0u;
    __syncthreads();
    XcdBarrier bar; bar.wv = F.wave; bar.bar = (unsigned*)(F.ctl + CW_BAR); bar.x = 0; bar.st = nullptr;
    if (N_LAUNCHES != PER_PHASE) bar = xcd_barrier_post((unsigned*)(F.ctl + CW_BAR), F.MISC + 8, F.wave);
#define GRID_BAR(seam) do { if (N_LAUNCHES == PER_PHASE) { if (F.wave == 0 && mk_lane() == 0) __hip_atomic_store(F.ctl + CW_TMO, 0xBADBA0u | (unsigned)(seam), RLX_AGENT); } else { xcd_barrier(bar); } } while (0)
    const int lo = args.ph_lo, hi = args.ph_hi;
#define IN(k) (lo <= (k) && (k) < hi)
#define BOTH(k) (IN(k) && IN((k) + 1))

    if (IN(0)) { for (int rep = 0; rep < (REPEAT_PHASE == 0 ? 2 : 1); ++rep) p0_prologue(F); if (BOTH(0)) GRID_BAR(0); }

    if (IN(1)) for (int rep = 0; rep < (REPEAT_PHASE == 1 ? 2 : 1); ++rep) {
        pg8::Gemm g{F.H, F.WinT, M, NINP, D}; pg8::StaticOrder S; S.init(M, NINP, F.G, (int)blockIdx.x);
        pg8::EpiBf16<0> E{F.P, NINP, nullptr, 0, 0, 1.f};
        pg8::gemm_phase<pg8::EpiBf16<0>, pg8::StaticOrder, PG8_ALIGN, PG8_SP2>(F.lds + RING_OFF, g, S, E, F.wave);
        if (rep == (REPEAT_PHASE == 1 ? 1 : 0) && BOTH(1)) GRID_BAR(1);
    }

    if (IN(2)) { p2_norms(F); if (BOTH(2)) GRID_BAR(2); }


    if (IN(4)) { for (int rep = 0; rep < (REPEAT_PHASE == 4 ? 2 : 1); ++rep) p3_attention_mixed(F); if (BOTH(4)) GRID_BAR(4); }

    if (IN(5)) {
        pg8::Gemm g{F.O, F.WoutT, M, D, DO}; pg8::StaticOrder S; S.init(M, D, F.G, (int)blockIdx.x);
        pg8::EpiBf16<0> E{F.Y, D, nullptr, 0, 0, 1.f};
        pg8::gemm_phase<pg8::EpiBf16<0>, pg8::StaticOrder, PG8_ALIGN, PG8_SP2>(F.lds + RING_OFF, g, S, E, F.wave);
        if (BOTH(5)) GRID_BAR(5);
    }

    if (IN(6)) { for (int rep = 0; rep < (REPEAT_PHASE == 6 ? 2 : 1); ++rep) p5_final(F); }
#undef IN
#undef BOTH
}

extern "C" void kernel_launch(void* const* d_in, const int* in_sizes, int n_in, void* d_out, int out_size, void* d_ws, size_t ws_size, hipStream_t stream) {
    static int grid = 0;
    if (grid == 0) {
        if (n_in != 14 || in_sizes[0] != M * D || out_size != M * D || ws_size < WS_END) { fprintf(stderr, "kernel_launch: unexpected shapes (n_in %d, in0 %d, out %d, ws %zu); nothing launched\n", n_in, n_in > 0 ? in_sizes[0] : -1, out_size, ws_size); grid = -1; return; }
        int dev = 0, cus = 0, per_cu = 0;
        if (hipGetDevice(&dev) != hipSuccess || hipDeviceGetAttribute(&cus, hipDeviceAttributeMultiprocessorCount, dev) != hipSuccess) { grid = -1; return; }
        if (hipFuncSetAttribute((const void*)fwd, hipFuncAttributeMaxDynamicSharedMemorySize, LDS_BYTES) != hipSuccess) { fprintf(stderr, "kernel_launch: hipFuncSetAttribute failed\n"); grid = -1; return; }
        if (hipOccupancyMaxActiveBlocksPerMultiprocessor(&per_cu, (const void*)fwd, NWAVES * 64, LDS_BYTES) != hipSuccess || per_cu < 1)
            fprintf(stderr, "kernel_launch: note: occupancy query reports %d workgroups per CU\n", per_cu);
        (void)hipGetLastError();
        grid = cus;
    }
    if (grid < 0) return;
    if (hipMemsetAsync((char*)d_ws + WS_CTL, 0, CTL_ZERO_BYTES, stream) != hipSuccess) return;
    Args a{};
    for (int i = 0; i < 14; ++i) a.in[i] = (const float*)d_in[i];
    a.out = (float*)d_out; a.ws = (unsigned char*)d_ws;
    for (int li = 0; li < N_LAUNCHES; ++li) {
        a.ph_lo = (N_LAUNCHES == PER_PHASE) ? li : 0; a.ph_hi = (N_LAUNCHES == PER_PHASE) ? li + 1 : PER_PHASE; a.li = li;
        hipLaunchKernelGGL(fwd, dim3(grid), dim3(NWAVES * 64), LDS_BYTES, stream, a);
        const hipError_t le = hipPeekAtLastError();
        if (le != hipSuccess) { fprintf(stderr, "kernel_launch: launch %d failed: %s\n", li, hipGetErrorName(le)); break; }
    }
}
```

```cpp
#include <hip/hip_runtime.h>
#include <cstdio>
#include <cstdint>
namespace pg8 {
#define PG8_LAS __attribute__((address_space(3)))
typedef unsigned short bf16_t;
typedef short bf16x8 __attribute__((ext_vector_type(8)));
typedef float f32x4 __attribute__((ext_vector_type(4)));
typedef unsigned u32x4 __attribute__((ext_vector_type(4)));
constexpr int BM = 256, BK = 64, HALF = 128, HTB = HALF * BK * 2  , STAGE_BYTES = 8 * HTB, NXCD = 8, WGM = 8;

__host__ __device__ __forceinline__ int lds_byte(int r, int c) { const int st = (r >> 4) * 2 + (c >> 5), rr = r & 15, cc = c & 31, ob = rr * 64 + cc * 2; return st * 1024 + (ob ^ (((ob >> 9) & 1) << 5)); }
__host__ __device__ __forceinline__ void stage_rc(int b, int& R, int& C) { const int st = b / 1024, sb = b % 1024, swz = sb ^ (((sb >> 9) & 1) << 5); R = (st >> 1) * 16 + swz / 64; C = (st & 1) * 32 + (swz % 64) / 2; }
__host__ __device__ __forceinline__ int perm32(int rho) { const int n = rho >> 4, i = rho & 15; return 8 * (i >> 2) + 4 * n + (i & 3); }

struct Unit { int pm, pn; };
struct Gemm { const bf16_t* A; const bf16_t* Bt; int M, N, K; };

struct StaticOrder {
    int nM, nN, nwg, G, c;
    __host__ __device__ void init(int M, int N, int G_, int c_) { nM = M / BM; nN = N / BM; nwg = nM * nN; G = G_; c = c_; }
    __host__ __device__ bool next(int i, Unit& u) const {
        const long L = (long)i * G + c; if (L >= nwg) return false;
        int wgid = (int)L; { const int q = nwg / NXCD, r = nwg % NXCD, xcd = wgid % NXCD, off = wgid / NXCD; wgid = (xcd < r ? xcd * (q + 1) : r * (q + 1) + (xcd - r) * q) + off; }
        const int nig = WGM * nN, gid = wgid / nig, fm = gid * WGM, gsz = (nM - fm) < WGM ? (nM - fm) : WGM;
        u.pm = fm + ((wgid % nig) % gsz); u.pn = (wgid % nig) / gsz; return true;
    }
    __device__ __forceinline__ void a_ready(const Unit&) const {}
    __device__ __forceinline__ void done(const Unit&) const {}
};

__device__ __forceinline__ unsigned cvt_pk_bf16(float lo, float hi) { unsigned r; asm volatile("v_cvt_pk_bf16_f32 %0, %1, %2" : "=v"(r) : "v"(lo), "v"(hi)); return r; }
typedef float f32x2 __attribute__((ext_vector_type(2)));
__device__ __forceinline__ f32x2 gelu_pk(f32x2 v) {
    const f32x2 av = __builtin_elementwise_abs(v), d = av * 0.2316418882f + 1.0f;
    f32x2 t; t.x = __builtin_amdgcn_rcpf(d.x); t.y = __builtin_amdgcn_rcpf(d.y);
    f32x2 q = t * 0.5307027145f + (-0.7265760135f); q = q * t + 0.7107068705f; q = q * t + (-0.142248368f); q = q * t + 0.127414796f; q = q * t;
    const f32x2 s = (v * v) * (-0.72134752044f);
    f32x2 e; e.x = __builtin_amdgcn_exp2f(s.x); e.y = __builtin_amdgcn_exp2f(s.y);
    const f32x2 m = v * (q * e), r = v - m;
    f32x2 o; o.x = v.x < 0.f ? m.x : r.x; o.y = v.y < 0.f ? m.y : r.y; return o;
}

template <int ACT  > struct EpiBf16 {
    static constexpr bool PERM = true, AFTER_DRAIN = false; static_assert(ACT == 0 || ACT == 1, "EpiBf16: ACT is 0 (none) or 1 (gelu_pk)");
    bf16_t* O; int ldc; const float* bias; int split_cols; size_t split_stride; float scale0;
    __device__ __forceinline__ void operator()(const f32x4 (&acc)[2][2][4][2], const Unit& u, int wr, int wc, int fr, int fq) const {
        const int row0 = u.pm * BM + wr * 64 + fr; int colt = u.pn * BM; bf16_t* base = O;
        float sc = 1.f; if (split_cols) { const int t = colt / split_cols; base += (size_t)t * split_stride; colt -= t * split_cols; if (t == 0) sc = scale0; }
        const int col0 = colt + wc * 32 + 8 * fq, bcol0 = u.pn * BM + wc * 32 + 8 * fq;
        f32x4 bv[2][2];
#pragma unroll
        for (int bj = 0; bj < 2; ++bj)
#pragma unroll
            for (int n = 0; n < 2; ++n) bv[bj][n] = bias ? *(const f32x4*)(bias + bcol0 + bj * HALF + 4 * n) : (f32x4){0.f, 0.f, 0.f, 0.f};
#pragma unroll
        for (int ai = 0; ai < 2; ++ai)
#pragma unroll
            for (int m = 0; m < 4; ++m) { bf16_t* rowp = base + (size_t)(row0 + ai * HALF + m * 16) * ldc + col0;
#pragma unroll
                for (int bj = 0; bj < 2; ++bj) { f32x4 v0 = acc[ai][bj][m][0] + bv[bj][0], v1 = acc[ai][bj][m][1] + bv[bj][1];
                    if (ACT == 1) { f32x2 a = gelu_pk((f32x2){v0[0], v0[1]}), b = gelu_pk((f32x2){v0[2], v0[3]}), c = gelu_pk((f32x2){v1[0], v1[1]}), d = gelu_pk((f32x2){v1[2], v1[3]});
                        v0 = (f32x4){a.x, a.y, b.x, b.y}; v1 = (f32x4){c.x, c.y, d.x, d.y}; }
                    v0 = v0 * sc; v1 = v1 * sc; u32x4 w; w.x = cvt_pk_bf16(v0[0], v0[1]); w.y = cvt_pk_bf16(v0[2], v0[3]); w.z = cvt_pk_bf16(v1[0], v1[1]); w.w = cvt_pk_bf16(v1[2], v1[3]);
                    __builtin_nontemporal_store(w, (u32x4*)(rowp + bj * HALF)); } }
    }
};

struct PanelStats {
    unsigned* xbuf;
    unsigned* cnt;
    unsigned* tmo;
    int ntn; float eps;
    unsigned code;
    __device__ __forceinline__ bool run(const f32x4 (&v)[2][2][4][2], const Unit& u, int wr, int wc, int fr, int fq, PG8_LAS unsigned char* lds, int wid, int lane) const {
        typedef float f32x2v __attribute__((ext_vector_type(2)));
        PG8_LAS f32x2v* P = (PG8_LAS f32x2v*)lds;
        PG8_LAS f32x2v* S = (PG8_LAS f32x2v*)(lds + 8192);
        PG8_LAS unsigned* flag = (PG8_LAS unsigned*)(lds + 8192 + 2048);
#pragma unroll
        for (int ai = 0; ai < 2; ++ai)
#pragma unroll
            for (int m = 0; m < 4; ++m) {
                float s = 0.f;
#pragma unroll
                for (int bj = 0; bj < 2; ++bj)
#pragma unroll
                    for (int n = 0; n < 2; ++n) { const f32x4 x = v[ai][bj][m][n]; s += (x[0] + x[1]) + (x[2] + x[3]); }
                s += __shfl_xor(s, 16); s += __shfl_xor(s, 32);
                const float mw = s * (1.0f / 64.0f); float q = 0.f;
#pragma unroll
                for (int bj = 0; bj < 2; ++bj)
#pragma unroll
                    for (int n = 0; n < 2; ++n) { const f32x4 d = v[ai][bj][m][n] - mw; q += (d[0] * d[0] + d[1] * d[1]) + (d[2] * d[2] + d[3] * d[3]); }
                q += __shfl_xor(q, 16); q += __shfl_xor(q, 32);
                if (fq == 0) P[(ai * HALF + wr * 64 + m * 16 + fr) * 4 + wc] = (f32x2v){mw, q};
            }
        asm volatile("s_waitcnt lgkmcnt(0)" ::: "memory"); __builtin_amdgcn_s_barrier(); asm volatile("" ::: "memory");
#if defined(BROKEN_EXCHANGE_NO_WAIT)
#warning BROKEN CONTROL BUILD: the row-statistics exchange does not wait; results are wrong by design
        if (blockIdx.x >= 64) { const long long t0_ = clock64(); while (clock64() - t0_ < 60000) __builtin_amdgcn_s_sleep(8); }
#endif
        const int row = wid * 32 + (lane & 31);
        if (lane < 32) {
            const f32x2v a = P[row * 4 + 0], b = P[row * 4 + 1], c = P[row * 4 + 2], d = P[row * 4 + 3];
            const float mt = (a.x + b.x + c.x + d.x) * 0.25f;
            const float da = a.x - mt, db = b.x - mt, dc = c.x - mt, dd = d.x - mt;
            const float m2 = (a.y + b.y) + (c.y + d.y) + 64.0f * ((da * da + db * db) + (dc * dc + dd * dd));
            unsigned long long* slot = (unsigned long long*)xbuf + ((size_t)(u.pm * BM + row) * 4 + u.pn);
            __hip_atomic_store(slot, ((unsigned long long)__float_as_uint(m2) << 32) | __float_as_uint(mt), __ATOMIC_RELAXED, __HIP_MEMORY_SCOPE_AGENT);
        }
        asm volatile("s_waitcnt vmcnt(0)" ::: "memory");
        if (lane == 0) __hip_atomic_fetch_add(cnt + 64 * u.pm, 1u, __ATOMIC_RELAXED, __HIP_MEMORY_SCOPE_AGENT);
        if (wid == 0) {
            bool dead = false; const unsigned long long t0 = __builtin_amdgcn_s_memrealtime(); const unsigned want = 8u * (unsigned)ntn;
            for (;;) {
#if defined(BROKEN_EXCHANGE_NO_WAIT)
                break;
#endif
                if ((unsigned)__builtin_amdgcn_readfirstlane(__hip_atomic_load(cnt + 64 * u.pm, __ATOMIC_RELAXED, __HIP_MEMORY_SCOPE_AGENT)) >= want) break;
                if (__builtin_amdgcn_s_memrealtime() - t0 > 2000000ull) {
                    if (lane == 0) { unsigned expect = 0u; __hip_atomic_compare_exchange_strong(tmo + 1, &expect, code | (unsigned)(u.pm & 0xff), __ATOMIC_RELAXED, __ATOMIC_RELAXED, __HIP_MEMORY_SCOPE_AGENT);
                                     __hip_atomic_store(tmo, 1u, __ATOMIC_RELAXED, __HIP_MEMORY_SCOPE_AGENT); }
                    dead = true; break; }
                __builtin_amdgcn_s_sleep(2);
            }
            __builtin_amdgcn_fence(__ATOMIC_ACQUIRE, "agent");
            if (lane == 0) flag[0] = dead ? 1u : 0u;
        }
        asm volatile("s_waitcnt vmcnt(0) lgkmcnt(0)" ::: "memory"); __builtin_amdgcn_s_barrier(); asm volatile("" ::: "memory");
        const bool bad = flag[0] != 0u;
        if (lane < 32) {
            const unsigned long long* slot = (const unsigned long long*)xbuf + (size_t)(u.pm * BM + row) * 4; float mt[4], m2[4]; float ms = 0.f;
#pragma unroll
            for (int t = 0; t < 4; ++t) { if (t < ntn) { const unsigned long long w = __hip_atomic_load(slot + t, __ATOMIC_RELAXED, __HIP_MEMORY_SCOPE_AGENT); mt[t] = __uint_as_float((unsigned)w); m2[t] = __uint_as_float((unsigned)(w >> 32)); } else { mt[t] = 0.f; m2[t] = 0.f; } ms += mt[t]; }
            const float mean = ms / (float)ntn; float q = 0.f;
#pragma unroll
            for (int t = 0; t < 4; ++t) if (t < ntn) { const float dm = mt[t] - mean; q += m2[t] + 256.0f * dm * dm; }
            S[row] = (f32x2v){mean, 1.0f / sqrtf(q / (256.0f * (float)ntn) + eps)};
        }
        asm volatile("s_waitcnt lgkmcnt(0)" ::: "memory"); __builtin_amdgcn_s_barrier(); asm volatile("" ::: "memory");
        return bad;
    }
};
struct EpiLnRes {
    static constexpr bool PERM = false, AFTER_DRAIN = true;
    const float* base; float* out; int ldc; const float* bias; PanelStats st; unsigned poison;
    __device__ __forceinline__ void fused(f32x4 (&acc)[2][2][4][2], const Unit& u, int wr, int wc, int fr, int fq, PG8_LAS unsigned char* lds, int wid, int lane) const {
        typedef float f32x2v __attribute__((ext_vector_type(2)));
        const PG8_LAS f32x2v* S = (const PG8_LAS f32x2v*)(lds + 8192);
        const int col0 = u.pn * BM + wc * 32 + 4 * fq;
#pragma unroll
        for (int bj = 0; bj < 2; ++bj)
#pragma unroll
            for (int n = 0; n < 2; ++n) { const f32x4 bv = bias ? *(const f32x4*)(bias + col0 + bj * HALF + n * 16) : (f32x4){0.f, 0.f, 0.f, 0.f};
#pragma unroll
                for (int ai = 0; ai < 2; ++ai)
#pragma unroll
                    for (int m = 0; m < 4; ++m) acc[ai][bj][m][n] += bv; }
        f32x4 pre[4][2][2];
#pragma unroll
        for (int m = 0; m < 4; ++m) { const size_t off = (size_t)(u.pm * BM + wr * 64 + m * 16 + fr) * ldc + col0;
#pragma unroll
            for (int bj = 0; bj < 2; ++bj)
#pragma unroll
                for (int n = 0; n < 2; ++n) pre[m][bj][n] = *(const f32x4*)(base + off + bj * HALF + n * 16); }
        const bool bad = st.run(acc, u, wr, wc, fr, fq, lds, wid, lane) || poison != 0u;
        const float qnan = __builtin_nanf("");
#pragma unroll
        for (int ai = 0; ai < 2; ++ai)
#pragma unroll
            for (int m = 0; m < 4; ++m) { const int r = ai * HALF + wr * 64 + m * 16 + fr; const f32x2v sr = S[r]; const size_t off = (size_t)(u.pm * BM + r) * ldc + col0;
#pragma unroll
                for (int bj = 0; bj < 2; ++bj)
#pragma unroll
                    for (int n = 0; n < 2; ++n) { const f32x4 bs = ai == 0 ? pre[m][bj][n] : *(const f32x4*)(base + off + bj * HALF + n * 16); f32x4 o = bs + (acc[ai][bj][m][n] - sr.x) * sr.y;
                        if (bad) o = (f32x4){qnan, qnan, qnan, qnan}; *(f32x4*)(out + off + bj * HALF + n * 16) = o; }
                if (m & 1) asm volatile("" ::: "memory"); }
    }
};
struct EpiLnResLn {
    static constexpr bool PERM = false, AFTER_DRAIN = true;
    const float* base; float* out; bf16_t* xn; int ldc; const float* bias; PanelStats st1, st2; unsigned poison;
    __device__ __forceinline__ void fused(f32x4 (&acc)[2][2][4][2], const Unit& u, int wr, int wc, int fr, int fq, PG8_LAS unsigned char* lds, int wid, int lane) const {
        typedef float f32x2v __attribute__((ext_vector_type(2))); typedef unsigned u32x2v __attribute__((ext_vector_type(2)));
        const PG8_LAS f32x2v* S = (const PG8_LAS f32x2v*)(lds + 8192);
        const int col0 = u.pn * BM + wc * 32 + 4 * fq;
#pragma unroll
        for (int bj = 0; bj < 2; ++bj)
#pragma unroll
            for (int n = 0; n < 2; ++n) { const f32x4 bv = bias ? *(const f32x4*)(bias + col0 + bj * HALF + n * 16) : (f32x4){0.f, 0.f, 0.f, 0.f};
#pragma unroll
                for (int ai = 0; ai < 2; ++ai)
#pragma unroll
                    for (int m = 0; m < 4; ++m) acc[ai][bj][m][n] += bv; }
        bool bad = st1.run(acc, u, wr, wc, fr, fq, lds, wid, lane) || poison != 0u;
        const float qnan = __builtin_nanf("");
#pragma unroll
        for (int ai = 0; ai < 2; ++ai)
#pragma unroll
            for (int m = 0; m < 4; ++m) { const int r = ai * HALF + wr * 64 + m * 16 + fr; const f32x2v sr = S[r]; const size_t off = (size_t)(u.pm * BM + r) * ldc + col0;
#pragma unroll
                for (int bj = 0; bj < 2; ++bj)
#pragma unroll
                    for (int n = 0; n < 2; ++n) { const f32x4 bs = *(const f32x4*)(base + off + bj * HALF + n * 16); acc[ai][bj][m][n] = bs + (acc[ai][bj][m][n] - sr.x) * sr.y; }
                asm volatile("" : "+v"(acc[ai][0][m][0]), "+v"(acc[ai][0][m][1]), "+v"(acc[ai][1][m][0]), "+v"(acc[ai][1][m][1]));
                if (m & 1) asm volatile("" ::: "memory"); }
        const bool bad1 = bad;
        bad = st2.run(acc, u, wr, wc, fr, fq, lds, wid, lane) || bad;
#pragma unroll
        for (int ai = 0; ai < 2; ++ai)
#pragma unroll
            for (int m = 0; m < 4; ++m) { const int r = ai * HALF + wr * 64 + m * 16 + fr; const f32x2v sr = S[r]; const size_t off = (size_t)(u.pm * BM + r) * ldc + col0;
#pragma unroll
                for (int bj = 0; bj < 2; ++bj)
#pragma unroll
                    for (int n = 0; n < 2; ++n) { const f32x4 x1 = acc[ai][bj][m][n]; *(f32x4*)(out + off + bj * HALF + n * 16) = bad1 ? (f32x4){qnan, qnan, qnan, qnan} : x1;
                        const f32x4 o = (x1 - sr.x) * sr.y; u32x2v w; w.x = cvt_pk_bf16(o[0], o[1]); w.y = cvt_pk_bf16(o[2], o[3]);
                        if (bad) { w.x = 0x7fc07fc0u; w.y = 0x7fc07fc0u; } *(u32x2v*)(xn + off + bj * HALF + n * 16) = w; }
                asm volatile("" ::: "memory"); }
    }
};

template <class Epi, class Sched, bool ALIGN_EPI = false, bool SP2 = false>
__device__ __forceinline__ void gemm_phase(PG8_LAS unsigned char* lds, const Gemm g, const Sched& S, const Epi& E, int wid_in) {
    const int lane = (int)__builtin_amdgcn_mbcnt_hi(~0u, __builtin_amdgcn_mbcnt_lo(~0u, 0u)), wid = wid_in, tid = wid * 64 + lane, wr = wid >> 2, wc = wid & 3, fr = lane & 15, fq = lane >> 4;
    const int K = g.K, nt = K / BK;
    unsigned voffA[2], voffB[2];
#pragma unroll
    for (int i = 0; i < 2; ++i) { int R, C; stage_rc(tid * 16 + i * 8192, R, C); const int Rb = Epi::PERM ? ((R & ~31) + perm32(R & 31)) : R;
        voffA[i] = (unsigned)(R * K + C) * 2u; voffB[i] = (unsigned)(Rb * K + C) * 2u; }
    const size_t kstep = (size_t)(BK * 2);
    const size_t hstep = (size_t)HALF * K * 2;
    const size_t tstep = 2 * hstep;
    const unsigned ldsw = (unsigned)wid * 1024u;
    const int aoff = lds_byte(wr * 64 + fr, fq * 8), boff = lds_byte(wc * 32 + fr, fq * 8);
#define PG8_SA(b, h) (((b) * 2 + (h)) * HTB)
#define PG8_SB(b, h) ((4 + (b) * 2 + (h)) * HTB)
#define PG8_STAGE(bufoff, gbase, voff) do { _Pragma("unroll") for (int _i = 0; _i < 2; ++_i) \
        __builtin_amdgcn_global_load_lds((const unsigned*)((const char*)(gbase) + (voff)[_i]), (PG8_LAS unsigned*)(lds + (bufoff) + ldsw + _i * 8192), 16, 0, 0); } while (0)
#define PG8_LDA(dst, b, h) do { _Pragma("unroll") for (int m = 0; m < 4; ++m) _Pragma("unroll") for (int k = 0; k < 2; ++k) dst[m][k] = *(const PG8_LAS bf16x8*)(lds + PG8_SA(b, h) + aoff + m * 2048 + k * 1024); } while (0)
#define PG8_LDB(dst, b, h) do { _Pragma("unroll") for (int n = 0; n < 2; ++n) _Pragma("unroll") for (int k = 0; k < 2; ++k) dst[n][k] = *(const PG8_LAS bf16x8*)(lds + PG8_SB(b, h) + boff + n * 2048 + k * 1024); } while (0)
#define PG8_MMA(ai, bj, At, Bt) do { __builtin_amdgcn_s_setprio(1); _Pragma("unroll") for (int m = 0; m < 4; ++m) _Pragma("unroll") for (int n = 0; n < 2; ++n) _Pragma("unroll") for (int k = 0; k < 2; ++k) \
        acc[ai][bj][m][n] = __builtin_amdgcn_mfma_f32_16x16x32_bf16(Bt[n][k], At[m][k], acc[ai][bj][m][n], 0, 0, 0); __builtin_amdgcn_s_setprio(0); } while (0)
#define PG8_WAIT_V(n) asm volatile("s_waitcnt vmcnt(" #n ")" ::: "memory")
#define PG8_WAIT_L(n) asm volatile("s_waitcnt lgkmcnt(" #n ")" ::: "memory")
#define PG8_BAR __builtin_amdgcn_s_barrier()
#define PG8_SCHED __builtin_amdgcn_sched_barrier(0)
    Unit cur, nxt; int ui = 0;
    if (!S.next(0, cur)) return;
    f32x4 acc[2][2][4][2];
#pragma unroll
    for (int a = 0; a < 2; ++a)
#pragma unroll
        for (int b = 0; b < 2; ++b)
#pragma unroll
            for (int m = 0; m < 4; ++m)
#pragma unroll
                for (int n = 0; n < 2; ++n) acc[a][b][m][n] = (f32x4){0.f, 0.f, 0.f, 0.f};
    bf16x8 At[4][2], B0[2][2], B1[2][2];
    const char* cA = (const char*)g.A + (size_t)cur.pm * tstep; const char* cB = (const char*)g.Bt + (size_t)cur.pn * tstep;
    S.a_ready(cur);
    if constexpr (SP2) {
        PG8_STAGE(PG8_SB(0, 0), cB, voffB); PG8_STAGE(PG8_SB(0, 1), cB + hstep, voffB); PG8_STAGE(PG8_SA(0, 0), cA, voffA); PG8_STAGE(PG8_SA(0, 1), cA + hstep, voffA);
        if (wr == 1) PG8_BAR;
        PG8_WAIT_V(2); PG8_BAR;
        PG8_STAGE(PG8_SB(1, 0), cB + kstep, voffB); PG8_STAGE(PG8_SA(1, 0), cA + kstep, voffA); PG8_STAGE(PG8_SB(1, 1), cB + hstep + kstep, voffB);
        PG8_WAIT_V(6); PG8_BAR;
    } else {
        PG8_STAGE(PG8_SB(0, 0), cB, voffB); PG8_STAGE(PG8_SA(0, 0), cA, voffA); PG8_STAGE(PG8_SB(0, 1), cB + hstep, voffB); PG8_STAGE(PG8_SA(0, 1), cA + hstep, voffA);
        if (wr == 1) PG8_BAR;
        PG8_WAIT_V(4); PG8_BAR;
        PG8_STAGE(PG8_SB(1, 0), cB + kstep, voffB); PG8_STAGE(PG8_SA(1, 0), cA + kstep, voffA); PG8_STAGE(PG8_SB(1, 1), cB + hstep + kstep, voffB);
        PG8_WAIT_V(6); PG8_BAR;
    }
    for (;;) {
        const bool has_next = S.next(ui + 1, nxt);
        const char* nA = has_next ? (const char*)g.A + (size_t)nxt.pm * tstep : cA; const char* nB = has_next ? (const char*)g.Bt + (size_t)nxt.pn * tstep : cB;
        for (int t = 0; t < nt; t += 2) {
            const bool last = (t == nt - 2);
            const char* a1 = cA + (size_t)(t + 1) * kstep;
            const char* a2 = last ? nA : cA + (size_t)(t + 2) * kstep; const char* b2 = last ? nB : cB + (size_t)(t + 2) * kstep;
            const char* a3 = a2 + kstep; const char* b3 = b2 + kstep;
            if (last && has_next) S.a_ready(nxt);
            if constexpr (SP2) {
            PG8_LDB(B0, 0, 0); PG8_LDB(B1, 0, 1); PG8_SCHED; PG8_LDA(At, 0, 0); PG8_STAGE(PG8_SA(1, 1), a1 + hstep, voffA);
            PG8_WAIT_V(8); PG8_WAIT_L(0); PG8_BAR; PG8_MMA(0, 0, At, B0); PG8_MMA(0, 1, At, B1); PG8_BAR; PG8_SCHED;
            PG8_LDA(At, 0, 1); PG8_STAGE(PG8_SB(0, 0), b2, voffB); PG8_STAGE(PG8_SB(0, 1), b2 + hstep, voffB); PG8_STAGE(PG8_SA(0, 0), a2, voffA);
            PG8_WAIT_V(8); PG8_WAIT_L(0); PG8_BAR; PG8_MMA(1, 0, At, B0); PG8_MMA(1, 1, At, B1); PG8_BAR; PG8_SCHED;
            PG8_LDB(B0, 1, 0); PG8_LDB(B1, 1, 1); PG8_SCHED; PG8_LDA(At, 1, 0); PG8_STAGE(PG8_SA(0, 1), a2 + hstep, voffA);
            PG8_WAIT_V(8); PG8_WAIT_L(0); PG8_BAR; PG8_MMA(0, 0, At, B0); PG8_MMA(0, 1, At, B1); PG8_BAR; PG8_SCHED;
            PG8_LDA(At, 1, 1); PG8_STAGE(PG8_SB(1, 0), b3, voffB); PG8_STAGE(PG8_SB(1, 1), b3 + hstep, voffB); PG8_STAGE(PG8_SA(1, 0), a3, voffA);
            PG8_WAIT_V(8); PG8_WAIT_L(0); PG8_BAR; PG8_MMA(1, 0, At, B0); PG8_MMA(1, 1, At, B1); PG8_BAR; PG8_SCHED;
            } else {
            PG8_LDB(B0, 0, 0); PG8_SCHED; PG8_LDA(At, 0, 0); PG8_STAGE(PG8_SA(1, 1), a1 + hstep, voffA);
            PG8_WAIT_L(8); PG8_BAR; PG8_WAIT_L(0); PG8_MMA(0, 0, At, B0); PG8_BAR; PG8_SCHED;
            PG8_LDB(B1, 0, 1); PG8_STAGE(PG8_SB(0, 0), b2, voffB);
            PG8_BAR; PG8_WAIT_L(0); PG8_MMA(0, 1, At, B1); PG8_BAR;
            PG8_LDA(At, 0, 1); PG8_STAGE(PG8_SA(0, 0), a2, voffA);
            PG8_BAR; PG8_WAIT_L(0); PG8_MMA(1, 0, At, B0); PG8_BAR; PG8_SCHED;
            PG8_STAGE(PG8_SB(0, 1), b2 + hstep, voffB);
            PG8_WAIT_V(6); PG8_BAR; PG8_MMA(1, 1, At, B1); PG8_BAR;
            PG8_LDB(B0, 1, 0); PG8_SCHED; PG8_LDA(At, 1, 0); PG8_STAGE(PG8_SA(0, 1), a2 + hstep, voffA);
            PG8_WAIT_L(8); PG8_BAR; PG8_WAIT_L(0); PG8_MMA(0, 0, At, B0); PG8_BAR; PG8_SCHED;
            PG8_LDB(B1, 1, 1); PG8_STAGE(PG8_SB(1, 0), b3, voffB);
            PG8_BAR; PG8_WAIT_L(0); PG8_MMA(0, 1, At, B1); PG8_BAR;
            PG8_LDA(At, 1, 1); PG8_STAGE(PG8_SA(1, 0), a3, voffA);
            PG8_BAR; PG8_WAIT_L(0); PG8_MMA(1, 0, At, B0); PG8_BAR; PG8_SCHED;
            PG8_STAGE(PG8_SB(1, 1), b3 + hstep, voffB);
            PG8_WAIT_V(6); PG8_BAR; PG8_MMA(1, 1, At, B1); PG8_BAR;
            }
        }
        if constexpr (ALIGN_EPI) { if (wr == 0) PG8_BAR; }
        if constexpr (!Epi::AFTER_DRAIN) { E(acc, cur, wr, wc, fr, fq); S.done(cur); }
        if (!has_next) break;
#pragma unroll
        for (int a = 0; a < 2; ++a)
#pragma unroll
            for (int b = 0; b < 2; ++b)
#pragma unroll
                for (int m = 0; m < 4; ++m)
#pragma unroll
                    for (int n = 0; n < 2; ++n) acc[a][b][m][n] = (f32x4){0.f, 0.f, 0.f, 0.f};
        cur = nxt; cA = nA; cB = nB; ++ui;
        if constexpr (ALIGN_EPI) { if (wr == 1) PG8_BAR; }
    }
    PG8_WAIT_V(0);
    if constexpr (!ALIGN_EPI) { if (wr == 0) PG8_BAR; }
    PG8_BAR;
    if constexpr (Epi::AFTER_DRAIN) { E.fused(acc, cur, wr, wc, fr, fq, lds, wid, lane); S.done(cur); }
#undef PG8_SA
#undef PG8_SB
#undef PG8_STAGE
#undef PG8_LDA
#undef PG8_LDB
#undef PG8_MMA
#undef PG8_WAIT_V
#undef PG8_WAIT_L
#undef PG8_BAR
#undef PG8_SCHED
}
}

#ifndef PG8_SP2
#define PG8_SP2 true
#endif
#ifndef PG8_ALIGN
#define PG8_ALIGN true
#endif
constexpr int NWAVES = 8;
#ifndef MK_N_LAUNCHES
#define MK_N_LAUNCHES 1
#endif
constexpr int N_LAUNCHES = MK_N_LAUNCHES;
constexpr int PER_PHASE = 7;

constexpr int BATCH = 16, T = 2048, D = 2048, M = BATCH * T;
constexpr int NIN = 8528, NINP = 8704;
constexpr int C_QA = 0, C_KA = 1024, C_VA = 2048, C_ZA = 3072, C_QB = 4096, C_CKV = 6144, C_ZB = 6400, C_IQ = 7424, C_IK = 8448, C_IW = 8512;
constexpr int DO = 2048;
constexpr int TOPK = 256;
constexpr float EPS = 1e-6f;

constexpr size_t MiB = 1u << 20;
constexpr size_t WS_CTL = 0, CTL_ZERO_BYTES = 1 * MiB;
constexpr size_t WS_WIN = 2 * MiB;
constexpr size_t WS_WOUT = 36 * MiB;
constexpr size_t WS_WUV = 44 * MiB;
constexpr size_t WS_CKV = 48 * MiB;
constexpr size_t WS_IK = 64 * MiB;
constexpr size_t WS_BM = 68 * MiB;
constexpr size_t WS_H = 76 * MiB;
constexpr size_t WS_P = 204 * MiB;
constexpr size_t WS_END = 748 * MiB;
constexpr int CW_TMO = 0, CW_CODE = 1;
constexpr int CW_BAR = 4096;

constexpr int RING_OFF = 0, RING_BYTES = 131072;
constexpr int LDSCTL_OFF = RING_BYTES, MISC_OFF = LDSCTL_OFF + 320;
constexpr int UP_OFF = MISC_OFF + 128;
constexpr int LDS_BYTES = 147456;
static_assert(UP_OFF + 8 * 1024 <= LDS_BYTES, "LDS map");
#define GAS __attribute__((address_space(1)))
#define LAS __attribute__((address_space(3)))
typedef unsigned short bf16;
typedef unsigned v4u __attribute__((ext_vector_type(4)));
typedef float f32x4 __attribute__((ext_vector_type(4)));
typedef short bf16x8 __attribute__((ext_vector_type(8)));
typedef GAS unsigned gu32;
typedef GAS unsigned long long gu64;
#define RLX_AGENT __ATOMIC_RELAXED, __HIP_MEMORY_SCOPE_AGENT
#define LDS_WAIT() asm volatile("s_waitcnt lgkmcnt(0)" ::: "memory")
#define VM_WAIT() asm volatile("s_waitcnt vmcnt(0)" ::: "memory")
__device__ __forceinline__ unsigned long long rt() { return __builtin_amdgcn_s_memrealtime(); }
__device__ __forceinline__ unsigned f2bf(float f) { unsigned u = __builtin_bit_cast(unsigned, f); return (u + 0x7fffu + ((u >> 16) & 1u)) >> 16; }
__device__ __forceinline__ unsigned pk2(float lo, float hi) { return f2bf(lo) | (f2bf(hi) << 16); }

#define XB_TMO      128
#define XB_XCNT(j)  (256  + 64 * (j))
#define XB_XSUB(j)  (1280 + 64 * (j))
#define XB_XGEN(j)  (2304 + 64 * (j))
#define XB_TOP      3328
#define XB_TOPGEN   3392
#define XCD_BAR_WORDS 3456
#define XB_SPIN_CAP (1u << 24)

__device__ __forceinline__ unsigned xb_ld(unsigned* p)              { return __hip_atomic_load(p, __ATOMIC_RELAXED, __HIP_MEMORY_SCOPE_AGENT); }
__device__ __forceinline__ unsigned xb_add(unsigned* p, unsigned v) { return __hip_atomic_fetch_add(p, v, __ATOMIC_RELAXED, __HIP_MEMORY_SCOPE_AGENT); }
__device__ __forceinline__ unsigned xb_xcc_id() { return (unsigned)__builtin_amdgcn_s_getreg((3 << 11) | 20) & 0xFu; }
#define XB_SPIN(cond, bar) do { unsigned _sp = 0; while (cond) { __builtin_amdgcn_s_sleep(1); \
    if ((++_sp & 255u) == 0u) { if (xb_ld(&(bar)[XB_TMO])) break; if (_sp > XB_SPIN_CAP) { atomicAdd(&(bar)[XB_TMO], 1u); break; } } } } while (0)

__device__ __forceinline__ int mk_lane() { return (int)__builtin_amdgcn_mbcnt_hi(~0u, __builtin_amdgcn_mbcnt_lo(~0u, 0u)); }
struct XcdBarrier {
    int wv;
    unsigned* bar; unsigned x;
    volatile LAS unsigned* st;
};

__device__ __forceinline__ XcdBarrier xcd_barrier_post(unsigned* bar, volatile LAS unsigned* st, int wv) {
    XcdBarrier b; b.wv = wv; b.bar = bar; b.x = xb_xcc_id(); b.st = st;
    if (wv == 0 && mk_lane() == 0) (void)xb_add(&bar[XB_XCNT(b.x)], 1u);
    return b;
}
__device__ __forceinline__ void xcd_barrier_complete(unsigned* bar, unsigned x, unsigned& nloc, unsigned& nx) {
    const unsigned G = gridDim.x * gridDim.y * gridDim.z;
    unsigned sum, cnt, mine, sp = 0u;
    for (;;) {
        sum = 0u; cnt = 0u; mine = 0u;
#pragma unroll
        for (unsigned j = 0; j < 16; ++j) { const unsigned c = xb_ld(&bar[XB_XCNT(j)]); sum += c; cnt += (c > 0u) ? 1u : 0u; mine = (j == x) ? c : mine; }
        if (sum == G) break;
        __builtin_amdgcn_s_sleep(1);
        if ((++sp & 255u) == 0u) { if (xb_ld(&bar[XB_TMO])) break; if (sp > XB_SPIN_CAP) { atomicAdd(&bar[XB_TMO], 1u); break; } }
    }
    nloc = mine > 0u ? mine : 1u; nx = cnt > 0u ? cnt : 1u;
}

__device__ __forceinline__ void xcd_barrier(const XcdBarrier& b) {
    asm volatile("s_waitcnt vmcnt(0)" ::: "memory");
    __syncthreads();
    if (b.wv == 0 && mk_lane() == 0) {
        unsigned* bar = b.bar;
        __builtin_amdgcn_s_waitcnt(0);
        unsigned nloc = b.st[0], nx = b.st[1];
        if (nloc == 0u) { xcd_barrier_complete(bar, b.x, nloc, nx); b.st[0] = nloc; b.st[1] = nx; }
        const unsigned old = xb_add(&bar[XB_XSUB(b.x)], 1u);
        const unsigned gen = old / nloc;
        if (old + 1u == (gen + 1u) * nloc) {
            __builtin_amdgcn_fence(__ATOMIC_RELEASE, "agent");
            asm volatile("s_waitcnt vmcnt(0)" ::: "memory");
            const unsigned og = xb_add(&bar[XB_TOP], 1u);
            const unsigned tg = og / nx;
            if (og + 1u == (tg + 1u) * nx) xb_add(&bar[XB_TOPGEN], 1u);
            else XB_SPIN(xb_ld(&bar[XB_TOPGEN]) == tg, bar);
            __builtin_amdgcn_fence(__ATOMIC_ACQUIRE, "agent");
            xb_add(&bar[XB_XGEN(b.x)], 1u);
            asm volatile("s_waitcnt vmcnt(0)" ::: "memory");
        } else {
            XB_SPIN(xb_ld(&bar[XB_XGEN(b.x)]) == gen, bar);
            __builtin_amdgcn_fence(__ATOMIC_ACQUIRE, "agent");
            asm volatile("s_waitcnt vmcnt(0)" ::: "memory");
        }
    }
    __syncthreads();
}
#ifndef REPEAT_PHASE
#define REPEAT_PHASE -1
#endif
struct Frame {
    LAS unsigned char* lds;
    volatile LAS unsigned* MISC;
    gu32* ctl;
    int wave;
    int vcu, G;
    const float *x, *g_pre, *w_in, *lq1, *lk1, *lq2, *lk2, *subln_g, *kvn_g, *ikn_g, *w_uv, *rel_bias, *w_out, *g_post;
    float* out;
    bf16 *WinT, *WoutT, *WuvT, *CKVn, *IKn, *H, *O, *P, *Y;
    unsigned* BM;
};

__device__ __forceinline__ float wave_sum(float v) {
#pragma unroll
    for (int o = 1; o < 64; o <<= 1) v += __shfl_xor(v, o);
    return v;
}
__device__ __forceinline__ float wave_max(float v) {
#pragma unroll
    for (int o = 1; o < 64; o <<= 1) v = fmaxf(v, __shfl_xor(v, o));
    return v;
}
__device__ __forceinline__ float bf2f(unsigned short b) { return __uint_as_float((unsigned)b << 16); }
__device__ __forceinline__ float bflo(unsigned w) { return __uint_as_float(w << 16); }
__device__ __forceinline__ float bfhi(unsigned w) { return __uint_as_float(w & 0xffff0000u); }
__device__ __forceinline__ float silu(float z) { return z * __builtin_amdgcn_rcpf(1.f + __builtin_amdgcn_exp2f(-1.4426950408889634f * z)); }
__device__ __forceinline__ int t5_bucket(int n) {
    if (n < 16) return n;
    return 16 + (n >= 19) + (n >= 21) + (n >= 24) + (n >= 27) + (n >= 31) + (n >= 35) + (n >= 40) + (n >= 46) + (n >= 52) + (n >= 59) + (n >= 67) + (n >= 77) + (n >= 87) + (n >= 99) + (n >= 113);
}

__device__ __forceinline__ void p0_transpose_item(const float* W, int K, int N, int nblk, bf16* WT, LAS float* scr, int item, int lane) {
    const int kb = item / nblk, nb = item % nblk, k0 = 64 * kb, n0 = 32 * nb;
    const int rr = lane >> 3, c4 = lane & 7; const bool ok = n0 + 4 * c4 < N;
    f32x4 v[8];
#pragma unroll
    for (int i = 0; i < 8; ++i) v[i] = ok ? *(const GAS f32x4*)(W + (size_t)(k0 + 8 * i + rr) * N + n0 + 4 * c4) : (f32x4){0.f, 0.f, 0.f, 0.f};
#pragma unroll
    for (int i = 0; i < 8; ++i) { LAS float* d = scr + (8 * i + rr) * 33 + 4 * c4; d[0] = v[i].x; d[1] = v[i].y; d[2] = v[i].z; d[3] = v[i].w; }
    LDS_WAIT(); asm volatile("" ::: "memory");
    const int c = lane & 7;
#pragma unroll
    for (int j = 0; j < 4; ++j) { const int n = (lane >> 3) + 8 * j; const LAS float* s = scr + (8 * c) * 33 + n;
        v4u o; o.x = pk2(s[0 * 33], s[1 * 33]); o.y = pk2(s[2 * 33], s[3 * 33]); o.z = pk2(s[4 * 33], s[5 * 33]); o.w = pk2(s[6 * 33], s[7 * 33]);
        *(GAS v4u*)(WT + (size_t)(n0 + n) * K + k0 + 8 * c) = o; }
    LDS_WAIT(); asm volatile("" ::: "memory");
}
__device__ __forceinline__ void rms_rows4_to_bf16(const float* xrow, const float* g, bf16* orow, int lane) {
    f32x4 v[4][8]; float s[4];
#pragma unroll
    for (int r = 0; r < 4; ++r) { const GAS f32x4* xr = (const GAS f32x4*)(xrow + (size_t)r * D) + lane;
#pragma unroll
        for (int j = 0; j < 8; ++j) v[r][j] = xr[64 * j]; }
#pragma unroll
    for (int r = 0; r < 4; ++r) { float a = 0.f;
#pragma unroll
        for (int j = 0; j < 8; ++j) a += (v[r][j].x * v[r][j].x + v[r][j].y * v[r][j].y) + (v[r][j].z * v[r][j].z + v[r][j].w * v[r][j].w);
        s[r] = a; }
#pragma unroll
    for (int o = 1; o < 64; o <<= 1) {
#pragma unroll
        for (int r = 0; r < 4; ++r) s[r] += __shfl_xor(s[r], o); }
    const GAS f32x4* gr = (const GAS f32x4*)g + lane;
#pragma unroll
    for (int r = 0; r < 4; ++r) { const float rstd = rsqrtf(s[r] * (1.f / D) + EPS); GAS unsigned long long* o8 = (GAS unsigned long long*)(orow + (size_t)r * D) + lane;
#pragma unroll
        for (int j = 0; j < 8; ++j) { const f32x4 gg = gr[64 * j];
            o8[64 * j] = (unsigned long long)pk2(v[r][j].x * rstd * gg.x, v[r][j].y * rstd * gg.y) | ((unsigned long long)pk2(v[r][j].z * rstd * gg.z, v[r][j].w * rstd * gg.w) << 32); } }
}
__device__ __forceinline__ void p0_prologue(Frame& F) {
    LAS float* scr = (LAS float*)(F.lds + RING_OFF + F.wave * 16384);
    const int gw = F.vcu * NWAVES + F.wave, NGW = F.G * NWAVES;
    constexpr int I_IN = (D / 64) * (NINP / 32), I_OUT = (DO / 64) * (D / 32);
    for (int it = gw; it < I_IN + I_OUT; it += NGW) {
        if (it < I_IN) p0_transpose_item(F.w_in, D, NIN, NINP / 32, F.WinT, scr, it, mk_lane());
        else p0_transpose_item(F.w_out, DO, D, D / 32, F.WoutT, scr, it - I_IN, mk_lane());
    }
    for (int e = (F.vcu * NWAVES + F.wave) * 64 + mk_lane(); e < 8 * 128 * 256; e += F.G * NWAVES * 64) { const int j = e & 7, ln = (e >> 3) & 63, i = (e >> 9) & 15, mt = (e >> 13) & 3, hh = e >> 15;
        const int d = 32 * mt + (ln & 31), c = 32 * (i >> 1) + 16 * (i & 1) + 8 * (j >> 2) + 4 * (ln >> 5) + (j & 3);
        F.WuvT[e] = (bf16)f2bf(F.w_uv[((size_t)hh * 256 + c) * 128 + d]); }
    for (int m = 4 * gw; m < M; m += 4 * NGW) rms_rows4_to_bf16(F.x + (size_t)m * D, F.g_pre, F.H + (size_t)m * D, mk_lane());
}

__device__ __forceinline__ void p2_norms(Frame& F) {
    const int gw = F.vcu * NWAVES + F.wave, NGW = F.G * NWAVES, lane = mk_lane();
    const f32x4 g = *((const GAS f32x4*)F.kvn_g + lane); const float gk = F.ikn_g[lane];
    for (int m0 = 4 * gw; m0 < M; m0 += 4 * NGW) {
        unsigned long long cv[4]; unsigned short kv16[4];
#pragma unroll
        for (int r = 0; r < 4; ++r) { const bf16* pr = F.P + (size_t)(m0 + r) * NINP; cv[r] = *(const GAS unsigned long long*)(pr + C_CKV + 4 * lane); kv16[r] = pr[C_IK + lane]; }
        float sc[4], sk[4], c0[4], c1[4], c2[4], c3[4], kv[4];
#pragma unroll
        for (int r = 0; r < 4; ++r) { c0[r] = bflo((unsigned)cv[r]); c1[r] = bfhi((unsigned)cv[r]); c2[r] = bflo((unsigned)(cv[r] >> 32)); c3[r] = bfhi((unsigned)(cv[r] >> 32)); kv[r] = bf2f(kv16[r]);
            sc[r] = (c0[r] * c0[r] + c1[r] * c1[r]) + (c2[r] * c2[r] + c3[r] * c3[r]); sk[r] = kv[r] * kv[r]; }
#pragma unroll
        for (int o = 1; o < 64; o <<= 1) {
#pragma unroll
            for (int r = 0; r < 4; ++r) { sc[r] += __shfl_xor(sc[r], o); sk[r] += __shfl_xor(sk[r], o); } }
#pragma unroll
        for (int r = 0; r < 4; ++r) { const float rc = rsqrtf(sc[r] * (1.f / 256.f) + EPS), rk = rsqrtf(sk[r] * (1.f / 64.f) + EPS); const size_t m = (size_t)(m0 + r);
            *((GAS unsigned long long*)(F.CKVn + m * 256) + lane) = (unsigned long long)pk2(c0[r] * rc * g.x, c1[r] * rc * g.y) | ((unsigned long long)pk2(c2[r] * rc * g.z, c3[r] * rc * g.w) << 32);
            F.IKn[m * 64 + lane] = (bf16)f2bf(kv[r] * rk * gk); }
    }
}

__device__ __forceinline__ void naive_diff_attn(Frame& F, int b, int h, int t, float lam, LAS float* L1, LAS float* L2, LAS float* qs) {
    const int lane = mk_lane(); const size_t row = (size_t)b * T + t;
    const bf16* Prow = F.P + row * NINP;
    qs[lane] = bf2f(Prow[C_QA + h * 64 + lane]); qs[64 + lane] = bf2f(Prow[C_QA + 512 + h * 64 + lane]);
    float m1 = -INFINITY, m2 = -INFINITY;
    for (int s0 = 0; s0 <= t; s0 += 64) { const int s = s0 + lane;
        if (s <= t) {
            const bf16* kr = F.P + ((size_t)b * T + s) * NINP + C_KA + h * 64;
            float a1 = 0.f, a2 = 0.f;
#pragma unroll
            for (int c = 0; c < 8; ++c) { const v4u k1 = *(const GAS v4u*)(kr + 8 * c), k2 = *(const GAS v4u*)(kr + 512 + 8 * c);
                const LAS float* q1 = qs + 8 * c; const LAS float* q2 = qs + 64 + 8 * c;
                a1 += q1[0] * bflo(k1.x) + q1[1] * bfhi(k1.x) + q1[2] * bflo(k1.y) + q1[3] * bfhi(k1.y) + q1[4] * bflo(k1.z) + q1[5] * bfhi(k1.z) + q1[6] * bflo(k1.w) + q1[7] * bfhi(k1.w);
                a2 += q2[0] * bflo(k2.x) + q2[1] * bfhi(k2.x) + q2[2] * bflo(k2.y) + q2[3] * bfhi(k2.y) + q2[4] * bflo(k2.z) + q2[5] * bfhi(k2.z) + q2[6] * bflo(k2.w) + q2[7] * bfhi(k2.w); }
            const float bias = F.rel_bias[t5_bucket(t - s) * 16 + h];
            a1 = a1 * 0.125f + bias; a2 = a2 * 0.125f + bias;
            L1[s] = a1; L2[s] = a2; m1 = fmaxf(m1, a1); m2 = fmaxf(m2, a2);
        } }
    m1 = wave_max(m1); m2 = wave_max(m2);
    float s1 = 0.f, s2 = 0.f;
    for (int s = lane; s <= t; s += 64) { const float e1 = __expf(L1[s] - m1), e2 = __expf(L2[s] - m2); L1[s] = e1; L2[s] = e2; s1 += e1; s2 += e2; }
    s1 = wave_sum(s1); s2 = wave_sum(s2);
    const float i1 = 1.f / s1, i2 = lam / s2;
    for (int s = lane; s <= t; s += 64) L1[s] = L1[s] * i1 - L2[s] * i2;
    float o0 = 0.f, o1 = 0.f; const bf16* vb = F.P + (size_t)b * T * NINP + C_VA + h * 128 + 2 * lane;
    for (int s = 0; s <= t; ++s) { const float a = L1[s]; const unsigned vv = *(const GAS unsigned*)(vb + (size_t)s * NINP); o0 += a * bflo(vv); o1 += a * bfhi(vv); }
    const float ss = wave_sum(o0 * o0 + o1 * o1); const float rs = rsqrtf(ss * (1.f / 128.f) + EPS) * 0.8f;
    const unsigned zz = *(const GAS unsigned*)(Prow + C_ZA + h * 128 + 2 * lane);
    const float r0 = o0 * rs * F.subln_g[2 * lane] * silu(bflo(zz)), r1 = o1 * rs * F.subln_g[2 * lane + 1] * silu(bfhi(zz));
    *(GAS unsigned*)(F.O + row * DO + h * 128 + 2 * lane) = pk2(r0, r1);
}

__device__ __forceinline__ unsigned skey(float f) { const unsigned u = __float_as_uint(f); return (u & 0x80000000u) ? ~u : (u | 0x80000000u); }
__device__ __forceinline__ void naive_dsa(Frame& F, int b, int t, LAS unsigned char* wl) {
    LAS float* S = (LAS float*)wl; LAS float* IQ = (LAS float*)(wl + 8192); LAS float* QH = (LAS float*)(wl + 12288); LAS float* PP = (LAS float*)(wl + 13312);
    LAS int* SEL = (LAS int*)(wl + 14336); LAS float* OL = (LAS float*)(wl + 15360);
    const int lane = mk_lane(); const size_t row = (size_t)b * T + t; const bf16* Prow = F.P + row * NINP;
    for (int i = lane; i < 1024; i += 64) IQ[i] = bf2f(Prow[C_IQ + i]);
    float w[16];
#pragma unroll
    for (int hh = 0; hh < 16; ++hh) w[hh] = bf2f(Prow[C_IW + hh]) * 0.25f;
    for (int s0 = 0; s0 <= t; s0 += 64) { const int s = s0 + lane;
        if (s <= t) {
            const bf16* kr = F.IKn + ((size_t)b * T + s) * 64;
            float acc[16];
#pragma unroll
            for (int hh = 0; hh < 16; ++hh) acc[hh] = 0.f;
#pragma unroll
            for (int c = 0; c < 8; ++c) { const v4u kk = *(const GAS v4u*)(kr + 8 * c);
                const float k0 = bflo(kk.x), k1 = bfhi(kk.x), k2 = bflo(kk.y), k3 = bfhi(kk.y), k4 = bflo(kk.z), k5 = bfhi(kk.z), k6 = bflo(kk.w), k7 = bfhi(kk.w);
#pragma unroll
                for (int hh = 0; hh < 16; ++hh) { const LAS float* q = IQ + hh * 64 + 8 * c;
                    acc[hh] += q[0] * k0 + q[1] * k1 + q[2] * k2 + q[3] * k3 + q[4] * k4 + q[5] * k5 + q[6] * k6 + q[7] * k7; } }
            float sc = 0.f;
#pragma unroll
            for (int hh = 0; hh < 16; ++hh) sc += w[hh] * fmaxf(acc[hh] * 0.125f, 0.f);
            S[s] = sc;
        } }
    const int n = t + 1; int nsel;
    if (n <= TOPK) { for (int i = lane; i < n; i += 64) SEL[i] = i; nsel = n; }
    else {
        unsigned thr = 0u;
        for (int bit = 31; bit >= 0; --bit) { const unsigned cand = thr | (1u << bit); int cnt = 0;
            for (int s0 = 0; s0 < n; s0 += 64) { const int s = s0 + lane; const bool ge = (s < n) && (skey(S[s]) >= cand); cnt += __popcll(__ballot(ge)); }
            if (cnt >= TOPK) thr = cand; }
        int cgt = 0;
        for (int s0 = 0; s0 < n; s0 += 64) { const int s = s0 + lane; const bool gt = (s < n) && (skey(S[s]) > thr); cgt += __popcll(__ballot(gt)); }
        const int need = TOPK - cgt; int pos = 0, eqseen = 0; const unsigned long long lt = (1ull << lane) - 1ull;
        for (int s0 = 0; s0 < n; s0 += 64) { const int s = s0 + lane; const bool valid = s < n; const unsigned k = valid ? skey(S[s]) : 0u;
            const bool gt = valid && k > thr, eq = valid && k == thr; const unsigned long long meq = __ballot(eq);
            const bool take = gt || (eq && (eqseen + __popcll(meq & lt)) < need); const unsigned long long mt = __ballot(take);
            if (take) SEL[pos + __popcll(mt & lt)] = s;
            pos += __popcll(mt); eqseen += __popcll(meq); }
        nsel = pos;
    }
    for (int h = 0; h < 8; ++h) {
#pragma unroll
        for (int i = 0; i < 4; ++i) QH[lane + 64 * i] = bf2f(Prow[C_QB + h * 256 + lane + 64 * i]);
        float lg[4]; float mx = -INFINITY;
#pragma unroll
        for (int i = 0; i < 4; ++i) { const int k = lane + 64 * i; lg[i] = -INFINITY;
            if (k < nsel) { const int s = SEL[k]; const bf16* cr = F.CKVn + ((size_t)b * T + s) * 256; float a = 0.f;
                for (int c = 0; c < 32; ++c) { const v4u kk = *(const GAS v4u*)(cr + 8 * c); const LAS float* q = QH + 8 * c;
                    a += q[0] * bflo(kk.x) + q[1] * bfhi(kk.x) + q[2] * bflo(kk.y) + q[3] * bfhi(kk.y) + q[4] * bflo(kk.z) + q[5] * bfhi(kk.z) + q[6] * bflo(kk.w) + q[7] * bfhi(kk.w); }
                lg[i] = a * 0.0625f + F.rel_bias[t5_bucket(t - s) * 16 + 8 + h]; mx = fmaxf(mx, lg[i]); } }
        mx = wave_max(mx); float sm = 0.f;
#pragma unroll
        for (int i = 0; i < 4; ++i) { lg[i] = (lane + 64 * i < nsel) ? __expf(lg[i] - mx) : 0.f; sm += lg[i]; }
        sm = wave_sum(sm); const float inv = 1.f / sm;
#pragma unroll
        for (int i = 0; i < 4; ++i) PP[lane + 64 * i] = lg[i] * inv;
        float o0 = 0.f, o1 = 0.f, o2 = 0.f, o3 = 0.f;
        for (int k = 0; k < nsel; ++k) { const int s = SEL[k]; const float p = PP[k];
            const unsigned long long cv = *(const GAS unsigned long long*)(F.CKVn + ((size_t)b * T + s) * 256 + 4 * lane);
            o0 += p * bflo((unsigned)cv); o1 += p * bfhi((unsigned)cv); o2 += p * bflo((unsigned)(cv >> 32)); o3 += p * bfhi((unsigned)(cv >> 32)); }
        OL[4 * lane] = o0; OL[4 * lane + 1] = o1; OL[4 * lane + 2] = o2; OL[4 * lane + 3] = o3;
        float a0 = 0.f, a1 = 0.f; const float* wu = F.w_uv + (size_t)h * 256 * 128 + 2 * lane;
        for (int c = 0; c < 256; ++c) { const float o = OL[c]; const float2 ww = *(const float2*)(wu + c * 128); a0 += o * ww.x; a1 += o * ww.y; }
        const unsigned zz = *(const GAS unsigned*)(Prow + C_ZB + h * 128 + 2 * lane);
        *(GAS unsigned*)(F.O + row * DO + 1024 + h * 128 + 2 * lane) = pk2(a0 * silu(bflo(zz)), a1 * silu(bfhi(zz)));
    }
}


typedef float f32x16 __attribute__((ext_vector_type(16)));
typedef short v4i16_t __attribute__((ext_vector_type(4)));
typedef float f32x2_t __attribute__((ext_vector_type(2))); typedef __bf16 bf16x2_t __attribute__((ext_vector_type(2)));
constexpr float LOG2E = 1.4426950408889634f;
#define MFMA32(a, b, c) __builtin_amdgcn_mfma_f32_32x32x16_bf16((a), (b), (c), 0, 0, 0)
__device__ __forceinline__ void glds16(const void* gsrc, unsigned lds_dst) { unsigned keep;
    asm volatile("s_mov_b32 %0, m0\n\ts_mov_b32 m0, %2\n\ts_nop 0\n\tglobal_load_lds_dwordx4 %1, off\n\ts_mov_b32 m0, %0" : "=&s"(keep) : "v"(gsrc), "s"(lds_dst) : "memory"); }
#define GLDS16(gp, lp) glds16((const void*)(gp), (unsigned)__builtin_amdgcn_readfirstlane((int)(unsigned)(size_t)(lp)))
#define DMA_WAIT_BAR() do { asm volatile("s_waitcnt vmcnt(0)" ::: "memory"); __syncthreads(); } while (0)
__device__ __forceinline__ unsigned cvtpk(float lo, float hi) { f32x2_t v = {lo, hi}; bf16x2_t b = __builtin_convertvector(v, bf16x2_t); return __builtin_bit_cast(unsigned, b); }
__device__ __forceinline__ float xhalf_max(float v) { auto rr = __builtin_amdgcn_permlane32_swap(__float_as_uint(v), __float_as_uint(v), false, false); return fmaxf(__uint_as_float(rr[0]), __uint_as_float(rr[1])); }
__device__ __forceinline__ float xhalf_sum(float v) { auto rr = __builtin_amdgcn_permlane32_swap(__float_as_uint(v), __float_as_uint(v), false, false); return __uint_as_float(rr[0]) + __uint_as_float(rr[1]); }
__device__ __forceinline__ bf16x8 pack8(const f32x16& x, int s) {
    v4u p; p.x = cvtpk(x[8 * s], x[8 * s + 1]); p.y = cvtpk(x[8 * s + 2], x[8 * s + 3]); p.z = cvtpk(x[8 * s + 4], x[8 * s + 5]); p.w = cvtpk(x[8 * s + 6], x[8 * s + 7]);
    return __builtin_bit_cast(bf16x8, p);
}
__device__ __forceinline__ bf16x8 tr_pair(LAS unsigned char* a0, LAS unsigned char* a1) {
    const v4i16_t lo = __builtin_amdgcn_ds_read_tr16_b64_v4i16((LAS v4i16_t*)a0), hi = __builtin_amdgcn_ds_read_tr16_b64_v4i16((LAS v4i16_t*)a1);
    return (bf16x8){lo[0], lo[1], lo[2], lo[3], hi[0], hi[1], hi[2], hi[3]};
}
template <int NB>
__device__ __forceinline__ void softmax_step(f32x16& x, float& mhat, float& lsum, f32x16 (&o)[NB]) {
    float mt = fmaxf(fmaxf(x[0], x[1]), fmaxf(x[2], x[3]));
#pragma unroll
    for (int i = 4; i < 16; i += 4) mt = fmaxf(mt, fmaxf(fmaxf(x[i], x[i + 1]), fmaxf(x[i + 2], x[i + 3])));
    mt = xhalf_max(mt);
    if (__any(mt > mhat + 8.f)) {
        const float mnew = fmaxf(mhat, mt), f = __builtin_amdgcn_exp2f(mhat - mnew);
        lsum *= f;
#pragma unroll
        for (int d = 0; d < NB; ++d) o[d] *= f;
        mhat = mnew;
    }
    x -= mhat;
#pragma unroll
    for (int i = 0; i < 16; ++i) x[i] = __builtin_amdgcn_exp2f(x[i]);
    const float a0 = (x[0] + x[1]) + (x[2] + x[3]), a1 = (x[4] + x[5]) + (x[6] + x[7]), a2 = (x[8] + x[9]) + (x[10] + x[11]), a3 = (x[12] + x[13]) + (x[14] + x[15]);
    lsum += (a0 + a1) + (a2 + a3);
}
template <int NB>
__device__ __forceinline__ void softmax_step_raw(f32x16& x, const float c, float& mhat, float& lsum, f32x16 (&o)[NB]) {
    float mt = fmaxf(fmaxf(x[0], x[1]), fmaxf(x[2], x[3]));
#pragma unroll
    for (int i = 4; i < 16; i += 4) mt = fmaxf(mt, fmaxf(fmaxf(x[i], x[i + 1]), fmaxf(x[i + 2], x[i + 3])));
    mt = xhalf_max(mt) * c;
    if (__any(mt > mhat + 8.f)) {
        const float mnew = fmaxf(mhat, mt), f = __builtin_amdgcn_exp2f(mhat - mnew);
        lsum *= f;
#pragma unroll
        for (int d = 0; d < NB; ++d) o[d] *= f;
        mhat = mnew;
    }
    x = x * c - mhat;
#pragma unroll
    for (int i = 0; i < 16; ++i) x[i] = __builtin_amdgcn_exp2f(x[i]);
    const float a0 = (x[0] + x[1]) + (x[2] + x[3]), a1 = (x[4] + x[5]) + (x[6] + x[7]), a2 = (x[8] + x[9]) + (x[10] + x[11]), a3 = (x[12] + x[13]) + (x[14] + x[15]);
    lsum += (a0 + a1) + (a2 + a3);
}
template <int NB>
__device__ __forceinline__ void softmax_step2(f32x16& x, f32x16& y, float& mhat, float& lsum, f32x16 (&o)[NB]) {
    float mt = fmaxf(fmaxf(x[0], x[1]), fmaxf(x[2], x[3])), mu = fmaxf(fmaxf(y[0], y[1]), fmaxf(y[2], y[3]));
#pragma unroll
    for (int i = 4; i < 16; i += 4) { mt = fmaxf(mt, fmaxf(fmaxf(x[i], x[i + 1]), fmaxf(x[i + 2], x[i + 3]))); mu = fmaxf(mu, fmaxf(fmaxf(y[i], y[i + 1]), fmaxf(y[i + 2], y[i + 3]))); }
    mt = xhalf_max(fmaxf(mt, mu));
    if (__any(mt > mhat + 8.f)) {
        const float mnew = fmaxf(mhat, mt), f = __builtin_amdgcn_exp2f(mhat - mnew);
        lsum *= f;
#pragma unroll
        for (int d = 0; d < NB; ++d) o[d] *= f;
        mhat = mnew;
    }
    float acc = 0.f, acd = 0.f;
#pragma unroll
    for (int i = 0; i < 16; ++i) { x[i] = __builtin_amdgcn_exp2f(x[i] - mhat); acc += x[i]; y[i] = __builtin_amdgcn_exp2f(y[i] - mhat); acd += y[i]; }
    lsum += acc + acd;
}

constexpr int AT_STAGE = 32768, AT_Q2 = 65536, AT_LUT = UP_OFF - RING_OFF;
constexpr int A_K1 = 0, A_K2 = 8192, A_V = 16384;
__device__ __forceinline__ void a_load_q(Frame& F, int b, int h, int qb, bf16x8 (&qn)[8]) {
    int lane = mk_lane(), w = F.wave; asm volatile("" : "+v"(lane), "+s"(w));
    const bf16* qrow = F.P + ((size_t)b * T + qb * 256 + 32 * w + (lane & 31)) * NINP + C_QA + h * 64 + 8 * (lane >> 5);
#pragma unroll
    for (int ks = 0; ks < 4; ++ks) { qn[ks] = *(const GAS bf16x8*)(qrow + 512 + 16 * ks); qn[4 + ks] = *(const GAS bf16x8*)(qrow + 16 * ks); }
}
__device__ __forceinline__ void a_unit(Frame& F, int b, int h, int qb, float lam, bf16x8 (&qn)[8], int nb, int nh, int nqb) {
    LAS unsigned char* L = F.lds + RING_OFF;
    int lane = mk_lane(), w = F.wave; asm volatile("" : "+v"(lane), "+s"(w));
    const int r32 = lane & 31, hi = lane >> 5;
    const int q0 = qb * 256, tq0 = q0 + 32 * w;
    const size_t rowb = (size_t)b * T;
    LAS float* LUT = (LAS float*)(L + AT_LUT);
    __syncthreads();
    if ((F.wave * 64 + mk_lane()) < 256) { const int dist = 191 - (F.wave * 64 + mk_lane()); LUT[(F.wave * 64 + mk_lane())] = (dist >= 0 && dist < 128) ? (F.rel_bias[t5_bucket(dist) * 16 + h] - F.rel_bias[31 * 16 + h]) * 8.f : 0.f; }
    LAS unsigned char* q2p = L + AT_Q2 + w * 8192 + lane * 16;
#pragma unroll
    for (int ks = 0; ks < 4; ++ks) { *(LAS bf16x8*)(q2p + 4096 + ks * 1024) = qn[4 + ks]; *(LAS bf16x8*)(q2p + ks * 1024) = qn[ks]; }
    f32x16 o1[4], o2[4];
#pragma unroll
    for (int d = 0; d < 4; ++d) { o1[d] = (f32x16){}; o2[d] = (f32x16){}; }
    float m1 = -1e30f, m2 = -1e30f, l1 = 0.f, l2 = 0.f;
    const int NT = (q0 + 256) / 64;
    const bf16* ksrc = F.P + (rowb + 32 * (w >> 2) + r32) * NINP + C_KA + h * 64 + 8 * (2 * (w & 3) + hi);
    const bf16* vsrc;
    { const int m = lane & 31, vrow = 32 * (w >> 2) + 16 * ((w >> 1) & 1) + 8 * (w & 1) + 4 * (m >> 4) + ((m >> 1) & 3), vd0 = 32 * (lane >> 5) + 16 * ((m >> 3) & 1) + 8 * (m & 1);
      vsrc = F.P + (rowb + vrow) * NINP + C_VA + h * 128 + vd0; }
#define A_ISSUE(t, st) do { const size_t go = (size_t)(t) * 64 * NINP; LAS unsigned char* sb_ = L + (st) * AT_STAGE; \
        GLDS16(ksrc + go, sb_ + A_K1 + 1024 * w); GLDS16(ksrc + go + 512, sb_ + A_K2 + 1024 * w); \
        GLDS16(vsrc + go, sb_ + A_V + 2048 * w); GLDS16(vsrc + go + 64, sb_ + A_V + 2048 * w + 1024); } while (0)
    A_ISSUE(0, 0);
    DMA_WAIT_BAR();
    const int tbase = tq0 + r32 - 4 * hi;
#define A_K(c_, sub_, ks_) (*(const LAS bf16x8*)(kp + ((c_) ? A_K2 : A_K1) + ((sub_) * 4 + (ks_)) * 1024))
#define A_Q(c_, ks_) (*(const LAS bf16x8*)(q2p + ((c_) ? 0 : 4096) + (ks_) * 1024))
#define A_VF(sub_, s_, db_) tr_pair(vp + ((((sub_) * 2 + (s_)) * 2 + 0) * 4 + (db_)) * 512, vp + ((((sub_) * 2 + (s_)) * 2 + 1) * 4 + (db_)) * 512)
#define A_EL(xv_, i_, mh_, ls_, mx_) do { mx_ = fmaxf(mx_, xv_[i_]); const float e_ = __builtin_amdgcn_exp2f(xv_[i_] * (0.125f * LOG2E) - (mh_)); xv_[i_] = e_; ls_ += e_; } while (0)
#define A_SB() __builtin_amdgcn_sched_barrier(0)
    int tfast = (tq0 >= 176) ? ((tq0 - 176) >> 6) + 1 : 1; if (tfast > NT) tfast = NT; if (tfast < 1) tfast = 1;
    for (int t = 0; t < 1; ++t) {
        const int st = t & 1;
        if (t + 1 < NT) A_ISSUE(t + 1, st ^ 1);
        LAS unsigned char* kp = L + st * AT_STAGE + lane * 16;
        LAS unsigned char* vp = L + st * AT_STAGE + A_V + lane * 8;
#pragma unroll
        for (int sub = 0; sub < 2; ++sub) {
            const int s0 = 64 * t + 32 * sub;
            if (s0 <= tq0 + 31) {
                const bool band = s0 + 144 > tq0;
                bf16x8 p1[2], p2[2];
                { f32x16 x = (f32x16){};
#pragma unroll
                  for (int ks = 0; ks < 4; ++ks) x = MFMA32(*(const LAS bf16x8*)(kp + A_K1 + (sub * 4 + ks) * 1024), *(const LAS bf16x8*)(q2p + 4096 + ks * 1024), x);
                  if (band) { const int db_ = tbase - s0; const LAS float* lp = LUT + (191 - db_);
#pragma unroll
                    for (int i = 0; i < 16; ++i) { const int o_ = (i & 3) + 8 * (i >> 2); const float v_ = x[i] + lp[o_]; x[i] = (db_ < o_) ? -INFINITY : v_; } }
                  softmax_step_raw<4>(x, 0.125f * LOG2E, m1, l1, o1);
                  p1[0] = pack8(x, 0); p1[1] = pack8(x, 1); }
                { f32x16 x = (f32x16){};
#pragma unroll
                  for (int ks = 0; ks < 4; ++ks) x = MFMA32(*(const LAS bf16x8*)(kp + A_K2 + (sub * 4 + ks) * 1024), *(const LAS bf16x8*)(q2p + ks * 1024), x);
                  if (band) { const int db_ = tbase - s0; const LAS float* lp = LUT + (191 - db_);
#pragma unroll
                    for (int i = 0; i < 16; ++i) { const int o_ = (i & 3) + 8 * (i >> 2); const float v_ = x[i] + lp[o_]; x[i] = (db_ < o_) ? -INFINITY : v_; } }
                  softmax_step_raw<4>(x, 0.125f * LOG2E, m2, l2, o2);
                  p2[0] = pack8(x, 0); p2[1] = pack8(x, 1); }
#pragma unroll
                for (int s = 0; s < 2; ++s)
#pragma unroll
                    for (int db = 0; db < 4; ++db) {
                        const bf16x8 vf = tr_pair(vp + (((sub * 2 + s) * 2 + 0) * 4 + db) * 512, vp + (((sub * 2 + s) * 2 + 1) * 4 + db) * 512);
                        o1[db] = MFMA32(vf, p1[s], o1[db]); o2[db] = MFMA32(vf, p2[s], o2[db]); }
            }
        }
        DMA_WAIT_BAR();
    }
    for (int t = 1; t < tfast; ++t) {
        const int st = t & 1;
        if (t + 1 < NT) A_ISSUE(t + 1, st ^ 1);
        LAS unsigned char* kp = L + st * AT_STAGE + lane * 16;
        LAS unsigned char* vp = L + st * AT_STAGE + A_V + lane * 8;
        {
            float mx1 = -INFINITY, mx2 = -INFINITY;
            bf16x8 pa[2], pb[2], pc[2], pd[2];
            { f32x16 xa = (f32x16){}, xb = (f32x16){};
#pragma unroll
              for (int ks = 0; ks < 4; ++ks) xa = MFMA32(A_K(0, 0, ks), A_Q(0, ks), xa);
              A_SB();
#pragma unroll
              for (int ks = 0; ks < 4; ++ks) { xb = MFMA32(A_K(1, 0, ks), A_Q(1, ks), xb);
                  A_EL(xa, 4 * ks, m1, l1, mx1); A_EL(xa, 4 * ks + 1, m1, l1, mx1); A_EL(xa, 4 * ks + 2, m1, l1, mx1); A_EL(xa, 4 * ks + 3, m1, l1, mx1); A_SB(); }
              pa[0] = pack8(xa, 0); pa[1] = pack8(xa, 1);
              f32x16 xc = (f32x16){};
#pragma unroll
              for (int ks = 0; ks < 4; ++ks) { xc = MFMA32(A_K(0, 1, ks), A_Q(0, ks), xc);
                  A_EL(xb, 4 * ks, m2, l2, mx2); A_EL(xb, 4 * ks + 1, m2, l2, mx2); A_EL(xb, 4 * ks + 2, m2, l2, mx2); A_EL(xb, 4 * ks + 3, m2, l2, mx2); A_SB(); }
              pb[0] = pack8(xb, 0); pb[1] = pack8(xb, 1);
              A_SB();
#pragma unroll
              for (int i = 0; i < 8; ++i) { o1[i & 3] = MFMA32(A_VF(0, i >> 2, i & 3), pa[i >> 2], o1[i & 3]); A_EL(xc, 2 * i, m1, l1, mx1); A_EL(xc, 2 * i + 1, m1, l1, mx1); A_SB(); }
              pc[0] = pack8(xc, 0); pc[1] = pack8(xc, 1); }
            { f32x16 xd = (f32x16){};
#pragma unroll
              for (int ks = 0; ks < 4; ++ks) xd = MFMA32(A_K(1, 1, ks), A_Q(1, ks), xd);
              A_SB();
#pragma unroll
              for (int i = 0; i < 8; ++i) { o2[i & 3] = MFMA32(A_VF(0, i >> 2, i & 3), pb[i >> 2], o2[i & 3]); A_EL(xd, 2 * i, m2, l2, mx2); A_EL(xd, 2 * i + 1, m2, l2, mx2); A_SB(); }
              pd[0] = pack8(xd, 0); pd[1] = pack8(xd, 1); }
            A_SB();
#pragma unroll
            for (int i = 0; i < 8; ++i) { const bf16x8 vf = A_VF(1, i >> 2, i & 3); o1[i & 3] = MFMA32(vf, pc[i >> 2], o1[i & 3]); o2[i & 3] = MFMA32(vf, pd[i >> 2], o2[i & 3]); }
            A_SB();
            mx1 = xhalf_max(mx1) * (0.125f * LOG2E); mx2 = xhalf_max(mx2) * (0.125f * LOG2E);
            if (__any(mx1 > m1 + 8.f)) { const float mnew = fmaxf(m1, mx1), f = __builtin_amdgcn_exp2f(m1 - mnew); l1 *= f;
#pragma unroll
                for (int d = 0; d < 4; ++d) o1[d] *= f;
                m1 = mnew; }
            if (__any(mx2 > m2 + 8.f)) { const float mnew = fmaxf(m2, mx2), f = __builtin_amdgcn_exp2f(m2 - mnew); l2 *= f;
#pragma unroll
                for (int d = 0; d < 4; ++d) o2[d] *= f;
                m2 = mnew; }
        }
        DMA_WAIT_BAR();
    }
    for (int t = tfast; t < NT; ++t) {
        const int st = t & 1;
        if (t + 1 < NT) A_ISSUE(t + 1, st ^ 1);
        LAS unsigned char* kp = L + st * AT_STAGE + lane * 16;
        LAS unsigned char* vp = L + st * AT_STAGE + A_V + lane * 8;
#pragma unroll
        for (int sub = 0; sub < 2; ++sub) {
            const int s0 = 64 * t + 32 * sub;
            if (s0 <= tq0 + 31) {
                const bool band = s0 + 144 > tq0;
                bf16x8 p1[2], p2[2];
                { f32x16 x = (f32x16){};
#pragma unroll
                  for (int ks = 0; ks < 4; ++ks) x = MFMA32(*(const LAS bf16x8*)(kp + A_K1 + (sub * 4 + ks) * 1024), *(const LAS bf16x8*)(q2p + 4096 + ks * 1024), x);
                  if (band) { const int db_ = tbase - s0; const LAS float* lp = LUT + (191 - db_);
#pragma unroll
                    for (int i = 0; i < 16; ++i) { const int o_ = (i & 3) + 8 * (i >> 2); const float v_ = x[i] + lp[o_]; x[i] = (db_ < o_) ? -INFINITY : v_; } }
                  softmax_step_raw<4>(x, 0.125f * LOG2E, m1, l1, o1);
                  p1[0] = pack8(x, 0); p1[1] = pack8(x, 1); }
                { f32x16 x = (f32x16){};
#pragma unroll
                  for (int ks = 0; ks < 4; ++ks) x = MFMA32(*(const LAS bf16x8*)(kp + A_K2 + (sub * 4 + ks) * 1024), *(const LAS bf16x8*)(q2p + ks * 1024), x);
                  if (band) { const int db_ = tbase - s0; const LAS float* lp = LUT + (191 - db_);
#pragma unroll
                    for (int i = 0; i < 16; ++i) { const int o_ = (i & 3) + 8 * (i >> 2); const float v_ = x[i] + lp[o_]; x[i] = (db_ < o_) ? -INFINITY : v_; } }
                  softmax_step_raw<4>(x, 0.125f * LOG2E, m2, l2, o2);
                  p2[0] = pack8(x, 0); p2[1] = pack8(x, 1); }
#pragma unroll
                for (int s = 0; s < 2; ++s)
#pragma unroll
                    for (int db = 0; db < 4; ++db) {
                        const bf16x8 vf = tr_pair(vp + (((sub * 2 + s) * 2 + 0) * 4 + db) * 512, vp + (((sub * 2 + s) * 2 + 1) * 4 + db) * 512);
                        o1[db] = MFMA32(vf, p1[s], o1[db]); o2[db] = MFMA32(vf, p2[s], o2[db]); }
            }
        }
        DMA_WAIT_BAR();
    }
#undef A_K
#undef A_Q
#undef A_VF
#undef A_EL
#undef A_SB
#undef A_ISSUE
    l1 = xhalf_sum(l1); l2 = xhalf_sum(l2);
    const float i1 = 1.f / l1, i2 = lam / l2;
    float ss = 0.f;
#pragma unroll
    for (int d = 0; d < 4; ++d)
#pragma unroll
        for (int i = 0; i < 16; ++i) { const float o = o1[d][i] * i1 - o2[d][i] * i2; o1[d][i] = o; ss += o * o; }
    ss = xhalf_sum(ss);
    const float rs = rsqrtf(ss * (1.f / 128.f) + EPS) * 0.8f;
    int lane2 = mk_lane(); asm volatile("" : "+v"(lane2));
    const int hie = lane2 >> 5; const size_t row = rowb + tq0 + (lane2 & 31);
    unsigned long long zq[16];
#pragma unroll
    for (int i = 0; i < 16; ++i) zq[i] = *(const GAS unsigned long long*)(F.P + row * NINP + C_ZA + h * 128 + 32 * (i >> 2) + 8 * (i & 3) + 4 * hie);
    a_load_q(F, nb, nh, nqb, qn);
#pragma unroll
    for (int d = 0; d < 4; ++d)
#pragma unroll
        for (int g = 0; g < 4; ++g) { const int d0 = 32 * d + 8 * g + 4 * hie;
            const unsigned long long zz = zq[4 * d + g];
            const f32x4 gg = *(const GAS f32x4*)(F.subln_g + d0);
            const float r0 = o1[d][4 * g] * rs * gg.x * silu(bflo((unsigned)zz)), r1 = o1[d][4 * g + 1] * rs * gg.y * silu(bfhi((unsigned)zz));
            const float r2 = o1[d][4 * g + 2] * rs * gg.z * silu(bflo((unsigned)(zz >> 32))), r3 = o1[d][4 * g + 3] * rs * gg.w * silu(bfhi((unsigned)(zz >> 32)));
            *(GAS unsigned long long*)(F.O + row * DO + h * 128 + d0) = (unsigned long long)cvtpk(r0, r1) | ((unsigned long long)cvtpk(r2, r3) << 32); }
}

constexpr int IX_STAGE = 16384;
__device__ __forceinline__ void idx_load_q(Frame& F, int b, int blk, bf16x8 (&afn)[4], v4u (&wn)[2]) {
    int lane = mk_lane(), w = F.wave; asm volatile("" : "+v"(lane), "+s"(w));
    const int r32 = lane & 31, hi = lane >> 5, tokm = (r32 >> 2) & 1, head = (r32 & 3) + 4 * (r32 >> 3); const size_t rowb = (size_t)b * T; const int t0 = 16 * blk;
    const bf16* qr = F.P + (rowb + t0 + 2 * w + tokm) * NINP + C_IQ + head * 64 + 8 * hi;
#pragma unroll
    for (int ks = 0; ks < 4; ++ks) afn[ks] = *(const GAS bf16x8*)(qr + 16 * ks);
    const bf16* wr = F.P + (rowb + t0 + 2 * w + hi) * NINP + C_IW;
    wn[0] = *(const GAS v4u*)wr; wn[1] = *(const GAS v4u*)(wr + 8);
}
__device__ __forceinline__ void idx_issue3(Frame& F, int b, int blk) {
    LAS unsigned char* L = F.lds + RING_OFF;
    int lane = mk_lane(), w = F.wave; asm volatile("" : "+v"(lane), "+s"(w));
    const int nst = (16 * blk + 16 + 127) >> 7;
    const bf16* isrc = F.IKn + ((size_t)b * T + 32 * (w >> 1) + (lane & 31)) * 64 + 16 * (2 * (w & 1)) + 8 * (lane >> 5);
#pragma unroll
    for (int s = 0; s < 3; ++s) { const size_t go = (size_t)(s < nst ? s : nst - 1) * 128 * 64; LAS unsigned char* sb_ = L + s * 16384 + 2048 * w; GLDS16(isrc + go, sb_); GLDS16(isrc + go + 16, sb_ + 1024); }
}
__device__ __forceinline__ void idx_unit(Frame& F, int b, int blk, bf16x8 (&afn)[4], v4u (&wn)[2], int nb, int nblk) {
    LAS unsigned char* L = F.lds + RING_OFF;
    int lane = mk_lane(), w = F.wave; asm volatile("" : "+v"(lane), "+s"(w));
    const int r32 = lane & 31, hi = lane >> 5;
    const int t0 = 16 * blk; const size_t rowb = (size_t)b * T;
    bf16x8 af[4]; float wq[16];
    { const v4u w0 = wn[0], w1 = wn[1];
#pragma unroll
      for (int ks = 0; ks < 4; ++ks) af[ks] = afn[ks];
      const float sc_ = 0.25f * 0.125f;
      wq[0] = bflo(w0.x) * sc_; wq[1] = bfhi(w0.x) * sc_; wq[2] = bflo(w0.y) * sc_; wq[3] = bfhi(w0.y) * sc_; wq[4] = bflo(w0.z) * sc_; wq[5] = bfhi(w0.z) * sc_; wq[6] = bflo(w0.w) * sc_; wq[7] = bfhi(w0.w) * sc_;
      wq[8] = bflo(w1.x) * sc_; wq[9] = bfhi(w1.x) * sc_; wq[10] = bflo(w1.y) * sc_; wq[11] = bfhi(w1.y) * sc_; wq[12] = bflo(w1.z) * sc_; wq[13] = bfhi(w1.z) * sc_; wq[14] = bflo(w1.w) * sc_; wq[15] = bfhi(w1.w) * sc_; }
    const int nst = (t0 + 16 + 127) >> 7;
    const bf16* isrc = F.IKn + (rowb + 32 * (w >> 1) + r32) * 64 + 16 * (2 * (w & 1)) + 8 * hi;
#define I_ISSUE(st_, buf_) do { const size_t go = (size_t)(st_) * 128 * 64; LAS unsigned char* sb_ = L + (buf_) * IX_STAGE + 2048 * w; GLDS16(isrc + go, sb_); GLDS16(isrc + go + 16, sb_ + 1024); } while (0)
#define I_CLAMP(s_) ((s_) < nst ? (s_) : nst - 1)
    asm volatile("s_waitcnt vmcnt(4)" ::: "memory"); __syncthreads();
#pragma unroll
    for (int ks = 0; ks < 4; ++ks) asm volatile("" : "+v"(af[ks]));
#pragma unroll
    for (int i = 0; i < 16; ++i) asm volatile("" : "+v"(wq[i]));
    float sc[64];
#pragma unroll
    for (int st = 0; st < 16; ++st) {
        if (st < nst) {
            I_ISSUE(I_CLAMP(st + 3), (st + 3) & 3);
            LAS unsigned char* kp = L + (st & 3) * IX_STAGE + lane * 16;
            { f32x16 pa = (f32x16){};
#pragma unroll
              for (int ks = 0; ks < 4; ++ks) pa = MFMA32(af[ks], *(const LAS bf16x8*)(kp + ks * 1024), pa);
              __builtin_amdgcn_sched_barrier(0);
#pragma unroll
              for (int j = 1; j < 4; ++j) { f32x16 ca = (f32x16){}; float s0_ = 0.f, s1_ = 0.f;
#pragma unroll
                  for (int ks = 0; ks < 4; ++ks) { ca = MFMA32(af[ks], *(const LAS bf16x8*)(kp + (j * 4 + ks) * 1024), ca);
                      s0_ += wq[4 * ks] * fmaxf(pa[4 * ks], 0.f); s1_ += wq[4 * ks + 1] * fmaxf(pa[4 * ks + 1], 0.f); s0_ += wq[4 * ks + 2] * fmaxf(pa[4 * ks + 2], 0.f); s1_ += wq[4 * ks + 3] * fmaxf(pa[4 * ks + 3], 0.f);
                      __builtin_amdgcn_sched_barrier(0); }
                  sc[4 * st + j - 1] = s0_ + s1_; pa = ca; }
              float s0_ = 0.f, s1_ = 0.f;
#pragma unroll
              for (int i = 0; i < 16; i += 2) { s0_ += wq[i] * fmaxf(pa[i], 0.f); s1_ += wq[i + 1] * fmaxf(pa[i + 1], 0.f); }
              sc[4 * st + 3] = s0_ + s1_; }
            asm volatile("s_waitcnt vmcnt(4)" ::: "memory"); __syncthreads();
        } else {
#pragma unroll
            for (int j = 0; j < 4; ++j) sc[4 * st + j] = 0.f;
        }
    }
    asm volatile("s_waitcnt vmcnt(0)" ::: "memory");
#undef I_CLAMP
#undef I_ISSUE
    idx_issue3(F, nb, nblk);
    idx_load_q(F, nb, nblk, afn, wn);
    const int t = t0 + 2 * w + hi, n = t + 1;
    unsigned m0 = 0u, m1 = 0u;
    if (t0 + 15 < TOPK) {
#pragma unroll
        for (int i = 0; i < 8; ++i) { const unsigned long long bm = __ballot(32 * i + r32 < n); m0 = (lane == i) ? (unsigned)bm : m0; m1 = (lane == i) ? (unsigned)(bm >> 32) : m1; }
    } else {
        unsigned key[64];
#pragma unroll
        for (int i = 0; i < 64; ++i) key[i] = (32 * i + r32 < n) ? skey(sc[i]) : 0u;
        const int ng = (t0 + 16 + 255) >> 8;
#define HALF_COUNTS(cl_, c0_, c1_) do { int x_ = (cl_); \
            x_ += __builtin_amdgcn_update_dpp(0, x_, 0x111, 0xf, 0xf, true); x_ += __builtin_amdgcn_update_dpp(0, x_, 0x112, 0xf, 0xf, true); \
            x_ += __builtin_amdgcn_update_dpp(0, x_, 0x114, 0xf, 0xf, true); x_ += __builtin_amdgcn_update_dpp(0, x_, 0x118, 0xf, 0xf, true); \
            c0_ = __builtin_amdgcn_readlane(x_, 15) + __builtin_amdgcn_readlane(x_, 31); c1_ = __builtin_amdgcn_readlane(x_, 47) + __builtin_amdgcn_readlane(x_, 63); } while (0)
        unsigned kmx = 0u, kmn = 0xffffffffu;
#pragma unroll
        for (int g = 0; g < 8; ++g) if (g < ng) {
#pragma unroll
            for (int i = 8 * g; i < 8 * g + 8; ++i) { kmx = max(kmx, key[i]); kmn = min(kmn, (32 * i + r32 < n) ? key[i] : 0xffffffffu); } }
#define IX_SWZ(pat_) do { kmx = max(kmx, (unsigned)__builtin_amdgcn_ds_swizzle((int)kmx, (pat_))); kmn = min(kmn, (unsigned)__builtin_amdgcn_ds_swizzle((int)kmn, (pat_))); } while (0)
        IX_SWZ(0x041f); IX_SWZ(0x081f); IX_SWZ(0x101f); IX_SWZ(0x201f); IX_SWZ(0x401f);
#undef IX_SWZ
        const unsigned dif = kmx ^ kmn;
        int hb = 31 - __clz((int)(dif | 1u));
        unsigned thr = (hb >= 31) ? 0u : (kmx & ~((2u << hb) - 1u));
        hb = max(hb, __shfl_xor(hb, 32));
        hb = __builtin_amdgcn_readfirstlane(hb);
        bool done = false;
        for (int bit = hb; bit >= 0; --bit) {
            const unsigned cand = thr | (1u << bit); int cl = 0;
#pragma unroll
            for (int g = 0; g < 8; ++g) if (g < ng) {
#pragma unroll
                for (int i = 8 * g; i < 8 * g + 8; ++i) cl += (key[i] >= cand) ? 1 : 0; }
            int c0, c1; HALF_COUNTS(cl, c0, c1);
            const int cnt = hi ? c1 : c0;
            if (!done && cnt >= TOPK) { thr = cand; done = (cnt == TOPK); }
            if (__ballot(!done) == 0ull) break;
        }
        int g0, g1;
        { int cl = 0;
#pragma unroll
          for (int g = 0; g < 8; ++g) if (g < ng) {
#pragma unroll
              for (int i = 8 * g; i < 8 * g + 8; ++i) cl += (key[i] > thr) ? 1 : 0; }
          HALF_COUNTS(cl, g0, g1); }
        const int need = TOPK - (hi ? g1 : g0); int e0 = 0, e1 = 0; const unsigned lt = (1u << r32) - 1u;
#pragma unroll
        for (int g = 0; g < 8; ++g) if (g < ng) {
#pragma unroll
            for (int i = 8 * g; i < 8 * g + 8; ++i) { const bool gt = key[i] > thr, eq = key[i] == thr; const unsigned long long meq = __ballot(eq);
                const unsigned mq = hi ? (unsigned)(meq >> 32) : (unsigned)meq; const int seen = hi ? e1 : e0;
                const bool take = gt || (eq && (seen + __popc(mq & lt)) < need); const unsigned long long bm = __ballot(take);
                m0 = (lane == i) ? (unsigned)bm : m0; m1 = (lane == i) ? (unsigned)(bm >> 32) : m1;
                e0 += __popc((unsigned)meq); e1 += __popc((unsigned)(meq >> 32)); } }
#undef HALF_COUNTS
    }
    F.BM[(rowb + t0 + 2 * w) * 64 + lane] = m0; F.BM[(rowb + t0 + 2 * w + 1) * 64 + lane] = m1;
}

constexpr int AT_LUTB = AT_LUT + 1024;
__device__ __forceinline__ void b_load_q(Frame& F, int b, int blk, bf16x8 (&qn)[16]) {
    int lane = mk_lane(), w = F.wave; asm volatile("" : "+v"(lane), "+s"(w));
    const bf16* qrow = F.P + ((size_t)b * T + 32 * blk + (lane & 31)) * NINP + C_QB + w * 256 + 8 * (lane >> 5);
#pragma unroll
    for (int ks = 0; ks < 16; ++ks) qn[ks] = *(const GAS bf16x8*)(qrow + 16 * ks);
}
__device__ __forceinline__ void b_unit(Frame& F, int b, int blk, bf16x8 (&qn)[16], int nb, int nblk) {
    LAS unsigned char* L = F.lds + RING_OFF;
    int lane = mk_lane(), w = F.wave; asm volatile("" : "+v"(lane), "+s"(w));
    const int r32 = lane & 31, hi = lane >> 5;
    const int t0 = 32 * blk; const size_t rowb = (size_t)b * T; const size_t row = rowb + t0 + r32;
    const LAS float* LUT = (const LAS float*)(L + AT_LUTB) + w * 256;
    __syncthreads();
    bf16x8 qf[8];
    LAS unsigned char* qpk = L + AT_Q2 + w * 8192 + lane * 16;
#pragma unroll
    for (int ks = 0; ks < 8; ++ks) { qf[ks] = qn[ks]; *(LAS bf16x8*)(qpk + ks * 1024) = qn[8 + ks]; }
    f32x16 o[8];
#pragma unroll
    for (int d = 0; d < 8; ++d) o[d] = (f32x16){};
    float mh = -1e30f, ls = 0.f;
    const int NS = (blk + 2) >> 1;
    const bf16* tsrc;
    { const int c = lane >> 4, a = (lane >> 2) & 3, bb = (lane & 3) ^ c;
      tsrc = F.CKVn + (rowb + 32 * (w >> 2) + 4 * bb + a) * 256 + 32 * (2 * (w & 3)) + 8 * c; }
#define B_ISSUE(st_, buf_) do { const size_t go = (size_t)(st_) * 64 * 256; LAS unsigned char* sb_ = L + (buf_) * AT_STAGE + (w >> 2) * 16384 + (w & 3) * 4096; \
        GLDS16(tsrc + go, sb_); GLDS16(tsrc + go + 4096, sb_ + 1024); GLDS16(tsrc + go + 32, sb_ + 2048); GLDS16(tsrc + go + 4096 + 32, sb_ + 3072); } while (0)
    B_ISSUE(0, 0);
    DMA_WAIT_BAR();
    const int tbase = t0 + r32 - 4 * hi;
    const unsigned* bmrow = F.BM + row * 64;
    const int ka = r32 & 3, kb = (r32 >> 2) & 3;
    const int kpe = (r32 >> 4) * 1024 + hi * 256 + (4 * ka + (kb ^ hi)) * 16, kpo = (r32 >> 4) * 1024 + (2 + hi) * 256 + (4 * ka + (kb ^ (2 + hi))) * 16;
    const int q4 = (lane >> 2) & 3, tc = 2 * ((lane >> 4) & 1) + ((lane & 3) >> 1);
    const int vp0 = tc * 256 + (4 * q4 + (hi ^ tc)) * 16 + 8 * (lane & 1), vp1 = tc * 256 + (4 * q4 + ((2 + hi) ^ tc)) * 16 + 8 * (lane & 1);
#pragma unroll
    for (int ks = 0; ks < 8; ++ks) asm volatile("" : "+v"(qf[ks]));
    unsigned long long wcur = *(const GAS unsigned long long*)bmrow;
    asm volatile("" : "+v"(wcur));
#define KRD(tau_, ks_) (*(const LAS bf16x8*)(sb + (tau_) * 16384 + ((ks_) >> 1) * 2048 + (((ks_) & 1) ? kpo : kpe)))
#define QRD(ks_) (*(const LAS bf16x8*)(qpk + ((ks_) - 8) * 1024))
#define VRD(tau_, s_, cb_) tr_pair(sb + (tau_) * 16384 + (cb_) * 2048 + (s_) * 1024 + vp0, sb + (tau_) * 16384 + (cb_) * 2048 + (s_) * 1024 + vp1)
#define SB0() __builtin_amdgcn_sched_barrier(0)
#define B_QK(xv_, tau_) do { xv_ = (f32x16){}; _Pragma("unroll") for (int ks = 0; ks < 16; ++ks) xv_ = MFMA32(KRD(tau_, ks), (ks < 8) ? qf[ks & 7] : QRD(ks), xv_); } while (0)
#define B_EL(xv_, i_, lp_, wsel_, mx_) do { const int o_ = ((i_) & 3) + 8 * ((i_) >> 2); const float v_ = xv_[i_] * (0.0625f * LOG2E) + (lp_)[o_]; const float m_ = ((wsel_) & (1u << o_)) ? v_ : -INFINITY; \
        mx_ = fmaxf(mx_, m_); const float e_ = __builtin_amdgcn_exp2f(m_ - mh); xv_[i_] = e_; ls += e_; } while (0)
    {
        LAS unsigned char* sb = L; f32x16 x; B_QK(x, 0);
        const unsigned wsel = (unsigned)wcur >> (4 * hi); const int db_ = tbase; const LAS float* lp_ = LUT + (db_ > 191 ? 0 : 191 - db_); float mt_ = -INFINITY;
#pragma unroll
        for (int i = 0; i < 16; ++i) { const int o_ = (i & 3) + 8 * (i >> 2); const float v_ = x[i] * (0.0625f * LOG2E) + lp_[o_]; mt_ = fmaxf(mt_, (wsel & (1u << o_)) ? v_ : -INFINITY); }
        mt_ = xhalf_max(mt_); mh = (mt_ > -1e30f) ? mt_ : 0.f;
    }
    for (int st = 0; st < NS; ++st) {
        unsigned long long wnext = 0ull;
        if (st + 1 < NS) { wnext = *(const GAS unsigned long long*)(bmrow + 2 * (st + 1)); B_ISSUE(st + 1, (st + 1) & 1); }
        LAS unsigned char* sb = L + (st & 1) * AT_STAGE;
        const unsigned wsel0 = (unsigned)wcur >> (4 * hi), wsel1 = (unsigned)(wcur >> 32) >> (4 * hi);
        const int db0 = tbase - 64 * st, db1 = db0 - 32;
        const LAS float* lp0 = LUT + (db0 > 191 ? 0 : 191 - db0); const LAS float* lp1 = LUT + (db1 > 191 ? 0 : 191 - db1);
        f32x16 x0, x1; float mx = -INFINITY;
        B_QK(x0, 0);
        SB0();
        x1 = (f32x16){};
        { bf16x8 kb[2], qb[2]; kb[0] = KRD(1, 0);
#pragma unroll
          for (int ks = 0; ks < 16; ++ks) { if (ks + 1 < 16) { kb[(ks + 1) & 1] = KRD(1, ks + 1); if (ks + 1 >= 8) qb[(ks + 1) & 1] = QRD(ks + 1); }
              x1 = MFMA32(kb[ks & 1], (ks < 8) ? qf[ks & 7] : qb[ks & 1], x1); B_EL(x0, ks, lp0, wsel0, mx); SB0(); } }
        bf16x8 pa[2]; pa[0] = pack8(x0, 0); pa[1] = pack8(x0, 1);
        SB0();
        { bf16x8 vb[2]; vb[0] = VRD(0, 0, 0);
#pragma unroll
          for (int i = 0; i < 16; ++i) { if (i + 1 < 16) vb[(i + 1) & 1] = VRD(0, (i + 1) >> 3, (i + 1) & 7);
              o[i & 7] = MFMA32(vb[i & 1], pa[i >> 3], o[i & 7]); B_EL(x1, i, lp1, wsel1, mx); SB0(); } }
        bf16x8 pb[2]; pb[0] = pack8(x1, 0); pb[1] = pack8(x1, 1);
        SB0();
#pragma unroll
        for (int s = 0; s < 2; ++s)
#pragma unroll
            for (int cb = 0; cb < 8; ++cb) o[cb] = MFMA32(VRD(1, s, cb), pb[s], o[cb]);
        SB0();
        mx = xhalf_max(mx);
        if (__any(mx > mh + 8.f)) {
            const float mnew = fmaxf(mh, mx), f = __builtin_amdgcn_exp2f(mh - mnew); ls *= f;
#pragma unroll
            for (int d = 0; d < 8; ++d) o[d] *= f;
            mh = mnew; }
        DMA_WAIT_BAR();
        asm volatile("" : "+v"(wnext)); wcur = wnext;
    }
#undef B_EL
#undef B_QK
#undef KRD
#undef QRD
#undef VRD
#undef SB0
#undef B_ISSUE
    ls = xhalf_sum(ls);
    const float inv = 1.f / ls;
    int lane2 = mk_lane(); asm volatile("" : "+v"(lane2));
    const int r32e = lane2 & 31, hie = lane2 >> 5; const size_t rowe = rowb + t0 + r32e;
    unsigned long long zz[16];
#pragma unroll
    for (int i = 0; i < 16; ++i) zz[i] = *(const GAS unsigned long long*)(F.P + rowe * NINP + C_ZB + w * 128 + 32 * (i >> 2) + 8 * (i & 3) + 4 * hie);
    b_load_q(F, nb, nblk, qn);
    LAS unsigned char* ofp = L + w * 16384 + lane2 * 16;
#pragma unroll
    for (int cb = 0; cb < 8; ++cb) { o[cb] *= inv; *(LAS bf16x8*)(ofp + (2 * cb) * 1024) = pack8(o[cb], 0); *(LAS bf16x8*)(ofp + (2 * cb + 1) * 1024) = pack8(o[cb], 1); }
    const bf16* wu = F.WuvT + (size_t)w * 4 * 16 * 512 + lane2 * 8;
#pragma unroll
    for (int mt = 0; mt < 4; ++mt) {
        bf16x8 wa[16];
#pragma unroll
        for (int i = 0; i < 16; ++i) wa[i] = *(const GAS bf16x8*)(wu + (size_t)(mt * 16 + i) * 512);
        __builtin_amdgcn_sched_barrier(0);
        f32x16 acc = (f32x16){};
#pragma unroll
        for (int i = 0; i < 16; ++i) acc = MFMA32(wa[i], *(const LAS bf16x8*)(ofp + i * 1024), acc);
#pragma unroll
        for (int g = 0; g < 4; ++g) { const int d0 = 32 * mt + 8 * g + 4 * hie; const unsigned long long z_ = zz[4 * mt + g];
            const float r0 = acc[4 * g] * silu(bflo((unsigned)z_)), r1 = acc[4 * g + 1] * silu(bfhi((unsigned)z_));
            const float r2 = acc[4 * g + 2] * silu(bflo((unsigned)(z_ >> 32))), r3 = acc[4 * g + 3] * silu(bfhi((unsigned)(z_ >> 32)));
            *(GAS unsigned long long*)(F.O + rowe * DO + 1024 + w * 128 + d0) = (unsigned long long)cvtpk(r0, r1) | ((unsigned long long)cvtpk(r2, r3) << 32); }
        __builtin_amdgcn_sched_barrier(0);
    }
}

#ifndef NAIVE_B
#define NAIVE_B 0
#endif
constexpr int QW_BASE = 150000;
struct WorkQ { int pass, nq, x, qo, par; };
__device__ __forceinline__ int wq_next(Frame& F, WorkQ& Q) {
    for (;;) {
        if (Q.qo >= 8) return -1;
        const int xq = (Q.x + Q.qo) & 7;
        volatile LAS unsigned* slot = F.MISC + 16 + Q.par;
        if (F.wave == 0 && mk_lane() == 0) *slot = __hip_atomic_fetch_add(F.ctl + QW_BASE + 64 * (8 * Q.pass + xq), 1u, __ATOMIC_RELAXED, __HIP_MEMORY_SCOPE_AGENT);
        __syncthreads();
        const int t = __builtin_amdgcn_readfirstlane((int)*slot); Q.par ^= 1;
        if (t < Q.nq) return (xq << 16) | t;
        ++Q.qo;
    }
}
__device__ __forceinline__ void p3_attention_mixed(Frame& F, const XcdBarrier& bar) {
    const int lane = mk_lane();
    float d1 = F.lq1[lane] * F.lk1[lane], d2 = F.lq2[lane] * F.lk2[lane];
    const float lam = __expf(wave_sum(d1)) - __expf(wave_sum(d2)) + 0.2f;
    for (int i = (F.wave * 64 + mk_lane()); i < 8 * 256; i += NWAVES * 64) { const int hh = i >> 8, dist = 191 - (i & 255);
        ((LAS float*)(F.lds + RING_OFF + AT_LUTB))[i] = (dist >= 0 && dist < 128) ? (F.rel_bias[t5_bucket(dist) * 16 + 8 + hh] - F.rel_bias[31 * 16 + 8 + hh]) * LOG2E : 0.f; }
    const int myx = (int)(blockIdx.x & 7);
#define A_DEC(tk_, b_, h_, qb_) const int b_ = ((tk_) >> 16) + 8 * ((tk_) & 1), h_ = (((tk_) & 0xffff) >> 1) & 7, qb_ = 7 - (((tk_) & 0xffff) >> 4)
    { WorkQ Q{0, 128, myx, 0, 0}; bf16x8 qa[8];
      int cur = wq_next(F, Q), nxt = (cur >= 0) ? wq_next(F, Q) : -1;
      if (cur >= 0) { A_DEC(cur, b0, h0, qb0); a_load_q(F, b0, h0, qb0, qa); }
#pragma unroll 1
      while (cur >= 0) { A_DEC(cur, b, h, qb); const int nn = nxt >= 0 ? nxt : cur; A_DEC(nn, nb, nh, nqb);
          a_unit(F, b, h, qb, lam, qa, nb, nh, nqb);
          cur = nxt; nxt = (cur >= 0) ? wq_next(F, Q) : -1; } }
#undef A_DEC
#define I_DEC(tk_, b_, blk_) const int b_ = ((tk_) >> 16) + 8 * ((tk_) & 1), blk_ = 127 - (((tk_) & 0xffff) >> 1)
    { WorkQ Q{1, 256, myx, 0, 0}; bf16x8 afn[4]; v4u wn[2];
      int cur = wq_next(F, Q), nxt = (cur >= 0) ? wq_next(F, Q) : -1;
      if (cur >= 0) { I_DEC(cur, b0, k0); __syncthreads(); idx_issue3(F, b0, k0); idx_load_q(F, b0, k0, afn, wn); }
#pragma unroll 1
      while (cur >= 0) { I_DEC(cur, b, blk); const int nn = nxt >= 0 ? nxt : cur; I_DEC(nn, nb, nblk);
          idx_unit(F, b, blk, afn, wn, nb, nblk);
          cur = nxt; nxt = (cur >= 0) ? wq_next(F, Q) : -1; } }
#undef I_DEC
    asm volatile("s_waitcnt vmcnt(0)" ::: "memory");
    xcd_barrier(bar);
#define B_DEC(tk_, b_, blk_) const int b_ = ((tk_) >> 16) + 8 * ((tk_) & 1), blk_ = 63 - (((tk_) & 0xffff) >> 1)
    { WorkQ Q{2, 128, myx, 0, 0}; bf16x8 qn[16];
      int cur = wq_next(F, Q), nxt = (cur >= 0) ? wq_next(F, Q) : -1;
      if (cur >= 0) { B_DEC(cur, b0, k0); b_load_q(F, b0, k0, qn); }
#pragma unroll 1
      while (cur >= 0) { B_DEC(cur, b, blk); const int nn = nxt >= 0 ? nxt : cur; B_DEC(nn, nb, nblk);
          b_unit(F, b, blk, qn, nb, nblk);
          cur = nxt; nxt = (cur >= 0) ? wq_next(F, Q) : -1; } }
#undef B_DEC
}

__device__ __forceinline__ void p5_final(Frame& F) {
    const int gw = F.vcu * NWAVES + F.wave, NGW = F.G * NWAVES, lane = mk_lane();
    for (int m = gw; m < M; m += NGW) {
        const GAS v4u* yr = (const GAS v4u*)(F.Y + (size_t)m * D) + lane; v4u y[4]; float s = 0.f;
#pragma unroll
        for (int j = 0; j < 4; ++j) { y[j] = yr[64 * j];
            const float a0 = bflo(y[j].x), a1 = bfhi(y[j].x), a2 = bflo(y[j].y), a3 = bfhi(y[j].y), a4 = bflo(y[j].z), a5 = bfhi(y[j].z), a6 = bflo(y[j].w), a7 = bfhi(y[j].w);
            s += (a0 * a0 + a1 * a1) + (a2 * a2 + a3 * a3) + (a4 * a4 + a5 * a5) + (a6 * a6 + a7 * a7); }
        const float rstd = rsqrtf(wave_sum(s) * (1.f / D) + EPS);
#pragma unroll
        for (int j = 0; j < 4; ++j) { const size_t e = (size_t)(64 * j + lane) * 8;
            const f32x4 x0 = *(const GAS f32x4*)(F.x + (size_t)m * D + e), x1 = *(const GAS f32x4*)(F.x + (size_t)m * D + e + 4);
            const f32x4 g0 = *(const GAS f32x4*)(F.g_post + e), g1 = *(const GAS f32x4*)(F.g_post + e + 4);
            f32x4 r0, r1;
            r0.x = x0.x + bflo(y[j].x) * rstd * g0.x; r0.y = x0.y + bfhi(y[j].x) * rstd * g0.y; r0.z = x0.z + bflo(y[j].y) * rstd * g0.z; r0.w = x0.w + bfhi(y[j].y) * rstd * g0.w;
            r1.x = x1.x + bflo(y[j].z) * rstd * g1.x; r1.y = x1.y + bfhi(y[j].z) * rstd * g1.y; r1.z = x1.z + bflo(y[j].w) * rstd * g1.z; r1.w = x1.w + bfhi(y[j].w) * rstd * g1.w;
            *(GAS f32x4*)(F.out + (size_t)m * D + e) = r0; *(GAS f32x4*)(F.out + (size_t)m * D + e + 4) = r1; }
    }
}

struct Args { const float* in[14]; float* out; unsigned char* ws; int ph_lo, ph_hi, li, pad; };
__global__ void __launch_bounds__(NWAVES * 64, 2) fwd(Args args) {
    extern __shared__ __attribute__((aligned(16))) unsigned char lds[];
    Frame F;
    F.lds = (LAS unsigned char*)lds;
    F.MISC = (volatile LAS unsigned*)(F.lds + MISC_OFF);
    F.wave = __builtin_amdgcn_readfirstlane((int)(threadIdx.x >> 6));
    F.G = gridDim.x; { const int bx = blockIdx.x; F.vcu = (F.G % 8 == 0) ? (bx % 8) * (F.G / 8) + bx / 8 : bx; }
    unsigned char* ws = args.ws;
    F.ctl = (gu32*)(ws + WS_CTL);
    F.x = args.in[0]; F.g_pre = args.in[1]; F.w_in = args.in[2]; F.lq1 = args.in[3]; F.lk1 = args.in[4]; F.lq2 = args.in[5]; F.lk2 = args.in[6]; F.subln_g = args.in[7];
    F.kvn_g = args.in[8]; F.ikn_g = args.in[9]; F.w_uv = args.in[10]; F.rel_bias = args.in[11]; F.w_out = args.in[12]; F.g_post = args.in[13]; F.out = args.out;
    F.WinT = (bf16*)(ws + WS_WIN); F.WoutT = (bf16*)(ws + WS_WOUT); F.WuvT = (bf16*)(ws + WS_WUV); F.CKVn = (bf16*)(ws + WS_CKV); F.IKn = (bf16*)(ws + WS_IK);
    F.H = (bf16*)(ws + WS_H); F.O = (bf16*)(ws + WS_H); F.P = (bf16*)(ws + WS_P); F.Y = (bf16*)(ws + WS_P); F.BM = (unsigned*)(ws + WS_BM);
    for (int u = F.wave * 64 + mk_lane(); u < (LDS_BYTES - LDSCTL_OFF) / 4; u += NWAVES * 64) ((LAS unsigned*)(F.lds + LDSCTL_OFF))[u] = 0u;
    __syncthreads();
    XcdBarrier bar; bar.wv = F.wave; bar.bar = (unsigned*)(F.ctl + CW_BAR); bar.x = 0; bar.st = nullptr;
    if (N_LAUNCHES != PER_PHASE) bar = xcd_barrier_post((unsigned*)(F.ctl + CW_BAR), F.MISC + 8, F.wave);
#define GRID_BAR(seam) do { if (N_LAUNCHES == PER_PHASE) { if (F.wave == 0 && mk_lane() == 0) __hip_atomic_store(F.ctl + CW_TMO, 0xBADBA0u | (unsigned)(seam), RLX_AGENT); } else { xcd_barrier(bar); } } while (0)
    const int lo = args.ph_lo, hi = args.ph_hi;
#define IN(k) (lo <= (k) && (k) < hi)
#define BOTH(k) (IN(k) && IN((k) + 1))

    if (IN(0)) { for (int rep = 0; rep < (REPEAT_PHASE == 0 ? 2 : 1); ++rep) p0_prologue(F); if (BOTH(0)) GRID_BAR(0); }

    if (IN(1)) for (int rep = 0; rep < (REPEAT_PHASE == 1 ? 2 : 1); ++rep) {
        pg8::Gemm g{F.H, F.WinT, M, NINP, D}; pg8::StaticOrder S; S.init(M, NINP, F.G, (int)blockIdx.x);
        pg8::EpiBf16<0> E{F.P, NINP, nullptr, 0, 0, 1.f};
        pg8::gemm_phase<pg8::EpiBf16<0>, pg8::StaticOrder, PG8_ALIGN, PG8_SP2>(F.lds + RING_OFF, g, S, E, F.wave);
        if (rep == (REPEAT_PHASE == 1 ? 1 : 0) && BOTH(1)) GRID_BAR(1);
    }

    if (IN(2)) { p2_norms(F); if (BOTH(2)) GRID_BAR(2); }


    if (IN(4)) { p3_attention_mixed(F, bar); if (BOTH(4)) GRID_BAR(4); }

    if (IN(5)) {
        pg8::Gemm g{F.O, F.WoutT, M, D, DO}; pg8::StaticOrder S; S.init(M, D, F.G, (int)blockIdx.x);
        pg8::EpiBf16<0> E{F.Y, D, nullptr, 0, 0, 1.f};
        pg8::gemm_phase<pg8::EpiBf16<0>, pg8::StaticOrder, PG8_ALIGN, PG8_SP2>(F.lds + RING_OFF, g, S, E, F.wave);
        if (BOTH(5)) GRID_BAR(5);
    }

    if (IN(6)) { for (int rep = 0; rep < (REPEAT_PHASE == 6 ? 2 : 1); ++rep) p5_final(F); }
#undef IN
#undef BOTH
}

extern "C" void kernel_launch(void* const* d_in, const int* in_sizes, int n_in, void* d_out, int out_size, void* d_ws, size_t ws_size, hipStream_t stream) {
    static int grid = 0;
    if (grid == 0) {
        if (n_in != 14 || in_sizes[0] != M * D || out_size != M * D || ws_size < WS_END) { fprintf(stderr, "kernel_launch: unexpected shapes (n_in %d, in0 %d, out %d, ws %zu); nothing launched\n", n_in, n_in > 0 ? in_sizes[0] : -1, out_size, ws_size); grid = -1; return; }
        int dev = 0, cus = 0, per_cu = 0;
        if (hipGetDevice(&dev) != hipSuccess || hipDeviceGetAttribute(&cus, hipDeviceAttributeMultiprocessorCount, dev) != hipSuccess) { grid = -1; return; }
        if (hipFuncSetAttribute((const void*)fwd, hipFuncAttributeMaxDynamicSharedMemorySize, LDS_BYTES) != hipSuccess) { fprintf(stderr, "kernel_launch: hipFuncSetAttribute failed\n"); grid = -1; return; }
        if (hipOccupancyMaxActiveBlocksPerMultiprocessor(&per_cu, (const void*)fwd, NWAVES * 64, LDS_BYTES) != hipSuccess || per_cu < 1)
            fprintf(stderr, "kernel_launch: note: occupancy query reports %d workgroups per CU\n", per_cu);
        (void)hipGetLastError();
        grid = cus;
    }
    if (grid < 0) return;
    if (hipMemsetAsync((char*)d_ws + WS_CTL, 0, CTL_ZERO_BYTES, stream) != hipSuccess) return;
    Args a{};
    for (int i = 0; i < 14; ++i) a.in[i] = (const float*)d_in[i];
    a.out = (float*)d_out; a.ws = (unsigned char*)d_ws;
    for (int li = 0; li < N_LAUNCHES; ++li) {
        a.ph_lo = (N_LAUNCHES == PER_PHASE) ? li : 0; a.ph_hi = (N_LAUNCHES == PER_PHASE) ? li + 1 : PER_PHASE; a.li = li;
        hipLaunchKernelGGL(fwd, dim3(grid), dim3(NWAVES * 64), LDS_BYTES, stream, a);
        const hipError_t le = hipPeekAtLastError();
        if (le != hipSuccess) { fprintf(stderr, "kernel_launch: launch %d failed: %s\n", li, hipGetErrorName(le)); break; }
    }
}
```
